# Optimizing an MI355X kernel written in HIP

```python
import jax, jax.numpy as jnp
from jax import lax
import numpy as np

D_MODEL = 1024
BATCH = 1
SEQ = 16384
DEPTH = 2
DEC_BATCH = 8
DEC_SEQ = 2048
PAST_LEN = 128

N_MIXERS = 2
N_LRU_LAYERS = (DEPTH + 1) // 2
N_ATTN_LAYERS = DEPTH // 2
D_FF = 2816
N_FFN_PER_LAYER = 2
LRU_WIDTH = D_MODEL
LRU_BLOCKS = 8
LRU_BLOCK_W = LRU_WIDTH // LRU_BLOCKS
CONV_W = 4
CONV_LEFT = 2
LRU_C = 8.0
N_DIRS = 2
N_LRU_GATES = 2
HEAD_DIM = 128
N_HEADS = D_MODEL // HEAD_DIM
GROUPS = ((128, 1), (512, 4), (2048, 16))
N_GROUPS = len(GROUPS)
ATTN_BLOCK = 64
ROPE_THETA = 10000.0
EPS = 1e-6

kernel_name = "hybrid_rglru_dilated_swa_encoder"


def _rmsnorm(x, g):
    xf = x.astype(jnp.float32)
    y = xf * lax.rsqrt(jnp.mean(xf * xf, axis=-1, keepdims=True) + EPS)
    return (y * g.astype(jnp.float32)).astype(x.dtype)


def _swiglu(x, w_in, w_out):
    gate, up = jnp.split(x @ w_in, 2, axis=-1)
    return (jax.nn.silu(gate) * up) @ w_out


def _linear_scan(a, b, reverse):
    def combine(l, r):
        return (l[0] * r[0], r[0] * l[1] + r[1])
    _, h = lax.associative_scan(combine, (a, b), axis=1, reverse=reverse)
    return h


def _rglru_block(h, w_in, b_in, conv_w, conv_b, gate_w, gate_b, lam, w_out, b_out):
    B, S, _ = h.shape
    y, u = jnp.split(h @ w_in + b_in, 2, axis=-1)
    y = jax.nn.gelu(y)
    up = jnp.pad(u, ((0, 0), (CONV_LEFT, CONV_W - 1 - CONV_LEFT), (0, 0)))
    u = conv_b + sum(up[:, k:k + S] * conv_w[k] for k in range(CONV_W))
    ub = u.reshape(B, S, LRU_BLOCKS, LRU_BLOCK_W)
    gates = jnp.einsum('bsni,dgnij->dgbsnj', ub, gate_w) + gate_b[:, :, None, None]
    gates = jax.nn.sigmoid(gates.astype(jnp.float32)).reshape(N_DIRS, N_LRU_GATES, B, S, LRU_WIDTH)
    r, ig = gates[:, 0], gates[:, 1]
    log_a = -LRU_C * r * jax.nn.softplus(-lam.astype(jnp.float32))[:, None, None, :]
    a = jnp.exp(log_a)
    bterm = jnp.sqrt(-jnp.expm1(2.0 * log_a)) * ig * u.astype(jnp.float32)[None]
    h_f = _linear_scan(a[0], bterm[0], reverse=False)
    h_b = _linear_scan(a[1], bterm[1], reverse=True)
    return ((h_f + h_b).astype(h.dtype) * y) @ w_out + b_out


def _rope(t):
    S = t.shape[1]
    half = HEAD_DIM // 2
    inv = ROPE_THETA ** (-2.0 * jnp.arange(half, dtype=jnp.float32) / HEAD_DIM)
    ang = jnp.arange(S, dtype=jnp.float32)[:, None] * inv[None, :]
    cos = jnp.cos(ang)[:, None, None, :]
    sin = jnp.sin(ang)[:, None, None, :]
    tf = t.astype(jnp.float32)
    t1, t2 = tf[..., :half], tf[..., half:]
    return jnp.concatenate([t1 * cos - t2 * sin, t2 * cos + t1 * sin], axis=-1).astype(t.dtype)


def _dilated_band(q, k, v, dil, reach):
    B, S, H, Dh = q.shape
    L = S // dil
    BLK = ATTN_BLOCK
    nb = -(-L // BLK)
    pad = nb * BLK - L

    def strided(t):
        return t.reshape(B, L, dil, H, Dh).transpose(0, 2, 1, 3, 4)

    qs, ks, vs = strided(q), strided(k), strided(v)
    qb = jnp.pad(qs, ((0, 0), (0, 0), (0, pad), (0, 0), (0, 0))).reshape(B, dil, nb, BLK, H, Dh)

    def key_windows(t):
        tp = jnp.pad(t, ((0, 0), (0, 0), (BLK, BLK + pad), (0, 0), (0, 0)))
        tb = tp.reshape(B, dil, nb + 2, BLK, H, Dh)
        return jnp.concatenate([tb[:, :, :-2], tb[:, :, 1:-1], tb[:, :, 2:]], axis=3)

    kw, vw = key_windows(ks), key_windows(vs)
    qi = jnp.arange(BLK)[:, None]
    km = jnp.arange(3 * BLK)[None, :]
    band = jnp.abs(km - BLK - qi) <= reach
    kidx = jnp.arange(nb)[:, None, None] * BLK - BLK + km[None]
    valid = band[None] & (kidx >= 0) & (kidx < L)

    s = jnp.einsum('brnqhe,brnkhe->brnhqk', qb, kw, preferred_element_type=jnp.float32)
    s = jnp.where(valid[:, None], s, -jnp.inf)
    lse = jax.nn.logsumexp(s, axis=-1)
    p = jnp.exp(s - lse[..., None])
    o = jnp.einsum('brnhqk,brnkhe->brnqhe', p, vw.astype(jnp.float32))
    o = o.reshape(B, dil, nb * BLK, H, Dh)[:, :, :L].transpose(0, 2, 1, 3, 4).reshape(B, S, H, Dh)
    lse = lse.transpose(0, 1, 2, 4, 3).reshape(B, dil, nb * BLK, H)[:, :, :L]
    lse = lse.transpose(0, 2, 1, 3).reshape(B, S, H)
    return o, lse


def _dilated_attention(h, w_qkv, q_gain, k_gain, w_o):
    B, S, _ = h.shape
    qkv = (h @ w_qkv).reshape(B, S, N_GROUPS, 3, N_HEADS, HEAD_DIM)
    q = _rmsnorm(qkv[:, :, :, 0], q_gain[:, None, :])
    k = _rmsnorm(qkv[:, :, :, 1], k_gain[:, None, :])
    v = qkv[:, :, :, 2]
    q = _rope(q) * (HEAD_DIM ** -0.5)
    k = _rope(k)
    outs, lses = [], []
    for gi, (window, dil) in enumerate(GROUPS):
        o, l = _dilated_band(q[:, :, gi], k[:, :, gi], v[:, :, gi], dil, window // (2 * dil))
        outs.append(o)
        lses.append(l)
    w = jax.nn.softmax(jnp.stack(lses), axis=0)
    o = jnp.einsum('gbsh,gbshe->bshe', w, jnp.stack(outs))
    return o.reshape(B, S, N_HEADS * HEAD_DIM).astype(h.dtype) @ w_o


def _trunk(x, norm_g, ffn_w_in, ffn_w_out, lru_w_in, lru_b_in, lru_conv_w, lru_conv_b,
           lru_gate_w, lru_gate_b, lru_lambda, lru_w_out, lru_b_out,
           attn_w_qkv, attn_q_gain, attn_k_gain, attn_w_o):
    for i in range(DEPTH):
        x = x + 0.5 * _swiglu(_rmsnorm(x, norm_g[i, 0]), ffn_w_in[i, 0], ffn_w_out[i, 0])
        hn = _rmsnorm(x, norm_g[i, 1])
        j = i // N_MIXERS
        if i % N_MIXERS == 0:
            x = x + _rglru_block(hn, lru_w_in[j], lru_b_in[j], lru_conv_w[j], lru_conv_b[j],
                                 lru_gate_w[j], lru_gate_b[j], lru_lambda[j], lru_w_out[j], lru_b_out[j])
        else:
            x = x + _dilated_attention(hn, attn_w_qkv[j], attn_q_gain[j], attn_k_gain[j], attn_w_o[j])
        x = x + 0.5 * _swiglu(_rmsnorm(x, norm_g[i, 2]), ffn_w_in[i, 1], ffn_w_out[i, 1])
    return x


def setup_inputs(seed: int = 0) -> dict:
    key = jax.random.key(seed)
    ks = jax.random.split(key, 20)
    f32 = jnp.float32
    nrm = lambda k, shape, scale: jax.random.normal(k, shape, f32) * scale
    a0 = jax.random.uniform(ks[10], (N_LRU_LAYERS, N_DIRS, LRU_WIDTH), f32, 0.9, 0.999)
    return {
        "x_prompt": nrm(ks[0], (BATCH, SEQ, D_MODEL), 1.0),
        "x_sample": nrm(ks[1], (DEC_BATCH, DEC_SEQ, D_MODEL), 1.0),
        "norm_g": 1.0 + nrm(ks[2], (DEPTH, 3, D_MODEL), 0.02),
        "ffn_w_in": nrm(ks[3], (DEPTH, N_FFN_PER_LAYER, D_MODEL, 2 * D_FF), D_MODEL ** -0.5),
        "ffn_w_out": nrm(ks[4], (DEPTH, N_FFN_PER_LAYER, D_FF, D_MODEL), D_FF ** -0.5),
        "lru_w_in": nrm(ks[5], (N_LRU_LAYERS, D_MODEL, 2 * LRU_WIDTH), D_MODEL ** -0.5),
        "lru_b_in": nrm(ks[6], (N_LRU_LAYERS, 2 * LRU_WIDTH), 0.01),
        "lru_conv_w": nrm(ks[7], (N_LRU_LAYERS, CONV_W, LRU_WIDTH), CONV_W ** -0.5),
        "lru_conv_b": nrm(ks[8], (N_LRU_LAYERS, LRU_WIDTH), 0.01),
        "lru_gate_w": nrm(ks[9], (N_LRU_LAYERS, N_DIRS, N_LRU_GATES, LRU_BLOCKS, LRU_BLOCK_W, LRU_BLOCK_W), LRU_BLOCK_W ** -0.5),
        "lru_gate_b": nrm(ks[11], (N_LRU_LAYERS, N_DIRS, N_LRU_GATES, LRU_BLOCKS, LRU_BLOCK_W), 0.01),
        "lru_lambda": jnp.log(a0) - jnp.log1p(-a0),
        "lru_w_out": nrm(ks[12], (N_LRU_LAYERS, LRU_WIDTH, D_MODEL), LRU_WIDTH ** -0.5),
        "lru_b_out": nrm(ks[13], (N_LRU_LAYERS, D_MODEL), 0.01),
        "attn_w_qkv": nrm(ks[14], (N_ATTN_LAYERS, D_MODEL, N_GROUPS * 3 * N_HEADS * HEAD_DIM), D_MODEL ** -0.5),
        "attn_q_gain": 1.0 + nrm(ks[15], (N_ATTN_LAYERS, N_GROUPS, HEAD_DIM), 0.02),
        "attn_k_gain": 1.0 + nrm(ks[16], (N_ATTN_LAYERS, N_GROUPS, HEAD_DIM), 0.02),
        "attn_w_o": nrm(ks[17], (N_ATTN_LAYERS, N_HEADS * HEAD_DIM, D_MODEL), (N_HEADS * HEAD_DIM) ** -0.5),
    }


def reference(x_prompt, x_sample, norm_g, ffn_w_in, ffn_w_out, lru_w_in, lru_b_in, lru_conv_w,
              lru_conv_b, lru_gate_w, lru_gate_b, lru_lambda, lru_w_out, lru_b_out,
              attn_w_qkv, attn_q_gain, attn_k_gain, attn_w_o):
    y_prompt = _trunk(x_prompt, norm_g, ffn_w_in, ffn_w_out, lru_w_in, lru_b_in, lru_conv_w, lru_conv_b,
                      lru_gate_w, lru_gate_b, lru_lambda, lru_w_out, lru_b_out,
                      attn_w_qkv, attn_q_gain, attn_k_gain, attn_w_o)
    y_sample = _trunk(x_sample, norm_g, ffn_w_in, ffn_w_out, lru_w_in, lru_b_in, lru_conv_w, lru_conv_b,
                      lru_gate_w, lru_gate_b, lru_lambda, lru_w_out, lru_b_out,
                      attn_w_qkv, attn_q_gain, attn_k_gain, attn_w_o)
    return (y_prompt, y_sample)
```

```cpp
#include <hip/hip_runtime.h>
#include <hip/hip_cooperative_groups.h>
#include <cstdio>
namespace cg = cooperative_groups;
namespace pg8 {
#define PG8_LAS __attribute__((address_space(3)))
typedef unsigned short bf16_t;
typedef short bf16x8 __attribute__((ext_vector_type(8)));
typedef float f32x4 __attribute__((ext_vector_type(4)));
typedef unsigned u32x4 __attribute__((ext_vector_type(4)));
constexpr int BM = 256, BK = 64, HALF = 128, HTB = HALF * BK * 2  , STAGE_BYTES = 8 * HTB, NXCD = 8, WGM = 8;

__host__ __device__ __forceinline__ int lds_byte(int r, int c) { const int st = (r >> 4) * 2 + (c >> 5), rr = r & 15, cc = c & 31, ob = rr * 64 + cc * 2; return st * 1024 + (ob ^ (((ob >> 9) & 1) << 5)); }
__host__ __device__ __forceinline__ void stage_rc(int b, int& R, int& C) { const int st = b / 1024, sb = b % 1024, swz = sb ^ (((sb >> 9) & 1) << 5); R = (st >> 1) * 16 + swz / 64; C = (st & 1) * 32 + (swz % 64) / 2; }
__host__ __device__ __forceinline__ int perm32(int rho) { const int n = rho >> 4, i = rho & 15; return 8 * (i >> 2) + 4 * n + (i & 3); }

struct Unit { int pm, pn; };
struct Gemm { const bf16_t* A; const bf16_t* Bt; int M, N, K; };

struct StaticOrder {
    int nM, nN, nwg, G, c;
    __host__ __device__ void init(int M, int N, int G_, int c_) { nM = M / BM; nN = N / BM; nwg = nM * nN; G = G_; c = c_; }
    __host__ __device__ bool next(int i, Unit& u) const {
        const long L = (long)i * G + c; if (L >= nwg) return false;
        int wgid = (int)L; { const int q = nwg / NXCD, r = nwg % NXCD, xcd = wgid % NXCD, off = wgid / NXCD; wgid = (xcd < r ? xcd * (q + 1) : r * (q + 1) + (xcd - r) * q) + off; }
        const int nig = WGM * nN, gid = wgid / nig, fm = gid * WGM, gsz = (nM - fm) < WGM ? (nM - fm) : WGM;
        u.pm = fm + ((wgid % nig) % gsz); u.pn = (wgid % nig) / gsz; return true;
    }
    __device__ __forceinline__ void a_ready(const Unit&) const {}
    __device__ __forceinline__ void done(const Unit&) const {}
};
__device__ __forceinline__ unsigned cvt_pk_bf16(float lo, float hi) { unsigned r; asm volatile("v_cvt_pk_bf16_f32 %0, %1, %2" : "=v"(r) : "v"(lo), "v"(hi)); return r; }
typedef float f32x2 __attribute__((ext_vector_type(2)));
template <class Epi, class Sched, bool STAMP = false>
__device__ __forceinline__ void gemm_phase(PG8_LAS unsigned char* lds, const Gemm g, const Sched& S, const Epi& E, unsigned long long* stamps) {
    int tid_o = threadIdx.x; asm volatile("" : "+v"(tid_o));
    const int tid = tid_o, wid = __builtin_amdgcn_readfirstlane(tid >> 6), lane = tid & 63, wr = wid >> 2, wc = wid & 3, fr = lane & 15, fq = lane >> 4;
    const int K = g.K, nt = K / BK;
    int ts_lo = 0, ts_hi = 0, nts = 0; const unsigned long long rt_entry = STAMP ? (unsigned long long)wall_clock64() : 0ull;
#define PG8_STAMP() do { if (STAMP && wid == 0 && nts < 64) { const unsigned long long _c = (unsigned long long)clock64(); \
        ts_lo = (lane == nts) ? (int)(unsigned)_c : ts_lo; ts_hi = (lane == nts) ? (int)(unsigned)(_c >> 32) : ts_hi; ++nts; } } while (0)
    PG8_STAMP();
    unsigned voffA[2], voffB[2];
#pragma unroll
    for (int i = 0; i < 2; ++i) { int R, C; stage_rc(tid * 16 + i * 8192, R, C); const int Rb = Epi::PERM ? ((R & ~31) + perm32(R & 31)) : R;
        voffA[i] = (unsigned)(R * K + C) * 2u; voffB[i] = (unsigned)(Rb * K + C) * 2u; }
    const size_t kstep = (size_t)(BK * 2);
    const size_t hstep = (size_t)HALF * K * 2;
    const size_t tstep = 2 * hstep;
    const unsigned ldsw = (unsigned)wid * 1024u;
    const int aoff = lds_byte(wr * 64 + fr, fq * 8), boff = lds_byte(wc * 32 + fr, fq * 8);
#define PG8_SA(b, h) (((b) * 2 + (h)) * HTB)
#define PG8_SB(b, h) ((4 + (b) * 2 + (h)) * HTB)
#define PG8_STAGE(bufoff, gbase, voff) do { _Pragma("unroll") for (int _i = 0; _i < 2; ++_i) \
        __builtin_amdgcn_global_load_lds((const unsigned*)((const char*)(gbase) + (voff)[_i]), (PG8_LAS unsigned*)(lds + (bufoff) + ldsw + _i * 8192), 16, 0, 0); } while (0)
#define PG8_LDA(dst, b, h) do { _Pragma("unroll") for (int m = 0; m < 4; ++m) _Pragma("unroll") for (int k = 0; k < 2; ++k) dst[m][k] = *(const PG8_LAS bf16x8*)(lds + PG8_SA(b, h) + aoff + m * 2048 + k * 1024); } while (0)
#define PG8_LDB(dst, b, h) do { _Pragma("unroll") for (int n = 0; n < 2; ++n) _Pragma("unroll") for (int k = 0; k < 2; ++k) dst[n][k] = *(const PG8_LAS bf16x8*)(lds + PG8_SB(b, h) + boff + n * 2048 + k * 1024); } while (0)
#define PG8_MMA(ai, bj, At, Bt) do { __builtin_amdgcn_s_setprio(1); _Pragma("unroll") for (int m = 0; m < 4; ++m) _Pragma("unroll") for (int n = 0; n < 2; ++n) _Pragma("unroll") for (int k = 0; k < 2; ++k) \
        acc[ai][bj][m][n] = __builtin_amdgcn_mfma_f32_16x16x32_bf16(Bt[n][k], At[m][k], acc[ai][bj][m][n], 0, 0, 0); __builtin_amdgcn_s_setprio(0); } while (0)
#define PG8_WAIT_V(n) asm volatile("s_waitcnt vmcnt(" #n ")" ::: "memory")
#define PG8_WAIT_L(n) asm volatile("s_waitcnt lgkmcnt(" #n ")" ::: "memory")
#define PG8_BAR __builtin_amdgcn_s_barrier()
#define PG8_SCHED __builtin_amdgcn_sched_barrier(0)
    Unit cur, nxt; int ui = 0;
    if (!S.next(0, cur)) return;
    f32x4 acc[2][2][4][2];
#pragma unroll
    for (int a = 0; a < 2; ++a)
#pragma unroll
        for (int b = 0; b < 2; ++b)
#pragma unroll
            for (int m = 0; m < 4; ++m)
#pragma unroll
                for (int n = 0; n < 2; ++n) acc[a][b][m][n] = (f32x4){0.f, 0.f, 0.f, 0.f};
    bf16x8 At[4][2], B0[2][2], B1[2][2];
    const char* cA = (const char*)g.A + (size_t)cur.pm * tstep; const char* cB = (const char*)g.Bt + (size_t)cur.pn * tstep;
    S.a_ready(cur);
    PG8_STAGE(PG8_SB(0, 0), cB, voffB); PG8_STAGE(PG8_SA(0, 0), cA, voffA); PG8_STAGE(PG8_SB(0, 1), cB + hstep, voffB); PG8_STAGE(PG8_SA(0, 1), cA + hstep, voffA);
    if (wr == 1) PG8_BAR;
    PG8_WAIT_V(4); PG8_BAR;
    PG8_STAGE(PG8_SB(1, 0), cB + kstep, voffB); PG8_STAGE(PG8_SA(1, 0), cA + kstep, voffA); PG8_STAGE(PG8_SB(1, 1), cB + hstep + kstep, voffB);
    PG8_WAIT_V(6); PG8_BAR;
    PG8_STAMP();
    for (;;) {
        const bool has_next = S.next(ui + 1, nxt);
        const char* nA = has_next ? (const char*)g.A + (size_t)nxt.pm * tstep : cA; const char* nB = has_next ? (const char*)g.Bt + (size_t)nxt.pn * tstep : cB;
        for (int t = 0; t < nt; t += 2) {
            const bool last = (t == nt - 2);
            const char* a1 = cA + (size_t)(t + 1) * kstep;
            const char* a2 = last ? nA : cA + (size_t)(t + 2) * kstep; const char* b2 = last ? nB : cB + (size_t)(t + 2) * kstep;
            const char* a3 = a2 + kstep; const char* b3 = b2 + kstep;
            if (last && has_next) S.a_ready(nxt);
            PG8_LDB(B0, 0, 0); PG8_SCHED; PG8_LDA(At, 0, 0); PG8_STAGE(PG8_SA(1, 1), a1 + hstep, voffA);
            PG8_WAIT_L(8); PG8_BAR; PG8_WAIT_L(0); PG8_MMA(0, 0, At, B0); PG8_BAR; PG8_SCHED;
            PG8_LDB(B1, 0, 1); PG8_STAGE(PG8_SB(0, 0), b2, voffB);
            PG8_BAR; PG8_WAIT_L(0); PG8_MMA(0, 1, At, B1); PG8_BAR;
            PG8_LDA(At, 0, 1); PG8_STAGE(PG8_SA(0, 0), a2, voffA);
            PG8_BAR; PG8_WAIT_L(0); PG8_MMA(1, 0, At, B0); PG8_BAR; PG8_SCHED;
            PG8_STAGE(PG8_SB(0, 1), b2 + hstep, voffB);
            PG8_WAIT_V(6); PG8_BAR; PG8_MMA(1, 1, At, B1); PG8_BAR;
            PG8_LDB(B0, 1, 0); PG8_SCHED; PG8_LDA(At, 1, 0); PG8_STAGE(PG8_SA(0, 1), a2 + hstep, voffA);
            PG8_WAIT_L(8); PG8_BAR; PG8_WAIT_L(0); PG8_MMA(0, 0, At, B0); PG8_BAR; PG8_SCHED;
            PG8_LDB(B1, 1, 1); PG8_STAGE(PG8_SB(1, 0), b3, voffB);
            PG8_BAR; PG8_WAIT_L(0); PG8_MMA(0, 1, At, B1); PG8_BAR;
            PG8_LDA(At, 1, 1); PG8_STAGE(PG8_SA(1, 0), a3, voffA);
            PG8_BAR; PG8_WAIT_L(0); PG8_MMA(1, 0, At, B0); PG8_BAR; PG8_SCHED;
            PG8_STAGE(PG8_SB(1, 1), b3 + hstep, voffB);
            PG8_WAIT_V(6); PG8_BAR; PG8_MMA(1, 1, At, B1); PG8_BAR;
        }
        PG8_STAMP();
        if constexpr (!Epi::AFTER_DRAIN) { E(acc, cur, wr, wc, fr, fq); S.done(cur); }
        PG8_STAMP();
        if (!has_next) break;
#pragma unroll
        for (int a = 0; a < 2; ++a)
#pragma unroll
            for (int b = 0; b < 2; ++b)
#pragma unroll
                for (int m = 0; m < 4; ++m)
#pragma unroll
                    for (int n = 0; n < 2; ++n) acc[a][b][m][n] = (f32x4){0.f, 0.f, 0.f, 0.f};
        cur = nxt; cA = nA; cB = nB; ++ui;
    }
    PG8_WAIT_V(0);
    if (wr == 0) PG8_BAR;
    PG8_BAR;
    if constexpr (Epi::AFTER_DRAIN) { E.fused(acc, cur, wr, wc, fr, fq, lds, wid, lane); S.done(cur); }
    PG8_STAMP();
    if (STAMP && wid == 0) { stamps[lane] = lane < nts ? (((unsigned long long)(unsigned)ts_hi << 32) | (unsigned)ts_lo) : 0ull;
        if (lane == 62) stamps[62] = rt_entry; if (lane == 63) stamps[63] = (unsigned long long)wall_clock64(); }
#undef PG8_STAMP
#undef PG8_SA
#undef PG8_SB
#undef PG8_STAGE
#undef PG8_LDA
#undef PG8_LDB
#undef PG8_MMA
#undef PG8_WAIT_V
#undef PG8_WAIT_L
#undef PG8_BAR
#undef PG8_SCHED
}
}

using pg8::f32x4; using pg8::bf16x8; using pg8::u32x4; using pg8::Unit;
typedef unsigned short u16;
typedef unsigned u32x2 __attribute__((ext_vector_type(2)));
typedef float f32x2v __attribute__((ext_vector_type(2)));
typedef __bf16 bfv2 __attribute__((ext_vector_type(2)));
#define LAS PG8_LAS
#define DI __device__ __forceinline__

constexpr int M = 32768, D = 1024, FF = 2816, S0 = 16384, S1 = 2048;
constexpr int LDS_BYTES = 131072;
constexpr int NPHASE = 28;

constexpr size_t W_FI0 = 0, W_FO0 = 11534336, W_FI1 = 17301504, W_FO1 = 28835840, W_X = 34603008;
constexpr size_t W_LRUIN = W_X, W_GATE = W_X + 4194304, W_LRUOUT = W_X + 5242880;
constexpr size_t W_QKV = W_X, W_WO = W_X + 18874368;
constexpr size_t WS_XB = 55574528, WS_SSQ = WS_XB + 67108864, WS_ROPE = WS_SSQ + 2097152, WS_BIG = WS_ROPE + 8388608;
constexpr size_t WS_HID = WS_BIG;
constexpr size_t WS_YB = WS_BIG, WS_UB = WS_BIG + 67108864, WS_PYB = WS_BIG + 134217728, WS_PYF = WS_XB;
constexpr size_t WS_SUMA = WS_BIG + 201326592, WS_SUMB = WS_SUMA + 2097152, WS_CF = WS_SUMB + 2097152, WS_CB = WS_CF + 1048576;
constexpr size_t WS_Q = WS_BIG, WS_K = WS_BIG + 50331648, WS_VT = WS_BIG + 100663296, WS_AO = WS_BIG + 150994944;
constexpr size_t WS_NRM = WS_AO + 67108864, WS_LSE = WS_NRM + 3145728, WS_END = WS_LSE + 786432;

struct Params { const float* in[18]; float* out; unsigned char* ws; };

DI int opaque_tid() { int t = threadIdx.x; asm volatile("" : "+v"(t)); return t; }
DI float bf2f(unsigned b) { return __uint_as_float(b << 16); }
DI unsigned pk2(float a, float b) { bfv2 r = __builtin_convertvector((f32x2v){a, b}, bfv2); return __builtin_bit_cast(unsigned, r); }
DI float sigm(float x) { return __builtin_amdgcn_rcpf(1.0f + __expf(-x)); }
DI float row_rstd(const float* ssq, int row) {
    const f32x4* p = (const f32x4*)(ssq + (size_t)row * 16);
    const f32x4 s = (p[0] + p[1]) + (p[2] + p[3]);
    return __builtin_amdgcn_rsqf(((s[0] + s[1]) + (s[2] + s[3])) * (1.0f / 1024.0f) + 1e-6f);
}

struct EpiFFN1 {
    static constexpr bool PERM = true, AFTER_DRAIN = false;
    u16* hid; const float* ssq;
    DI void operator()(const f32x4 (&acc)[2][2][4][2], const Unit& u, int wr, int wc, int fr, int fq) const {
        const int row0 = u.pm * 256 + wr * 64 + fr, col0 = u.pn * 128 + wc * 32 + fq * 8;
#pragma unroll
        for (int ai = 0; ai < 2; ++ai)
#pragma unroll
            for (int m = 0; m < 4; ++m) {
                const int row = row0 + ai * 128 + m * 16; const float rs = row_rstd(ssq, row);
                u32x4 w;
#pragma unroll
                for (int n = 0; n < 2; ++n) {
                    const f32x4 g = acc[ai][0][m][n] * rs, up = acc[ai][1][m][n] * rs; float h[4];
#pragma unroll
                    for (int e = 0; e < 4; ++e) h[e] = g[e] * sigm(g[e]) * up[e];
                    w[2 * n] = pk2(h[0], h[1]); w[2 * n + 1] = pk2(h[2], h[3]);
                }
                *(u32x4*)(hid + (size_t)row * FF + col0) = w;
                asm volatile("" ::: "memory");
            }
    }
};
struct EpiResid {
    static constexpr bool PERM = false, AFTER_DRAIN = false;
    const float* base0; const float* base1; float* out; u16* xb; float* ssq; const float* bias; float scale;
    DI void operator()(const f32x4 (&acc)[2][2][4][2], const Unit& u, int wr, int wc, int fr, int fq) const {
        const int row0 = u.pm * 256 + wr * 64 + fr, col0 = u.pn * 256 + wc * 32 + fq * 4;
        f32x4 bv[2][2];
#pragma unroll
        for (int bj = 0; bj < 2; ++bj)
#pragma unroll
            for (int n = 0; n < 2; ++n) bv[bj][n] = bias ? *(const f32x4*)(bias + col0 + bj * 128 + n * 16) : (f32x4){0.f, 0.f, 0.f, 0.f};
#pragma unroll
        for (int ai = 0; ai < 2; ++ai)
#pragma unroll
            for (int m = 0; m < 4; ++m) {
                const int row = row0 + ai * 128 + m * 16;
                const float* bp = (row < S0 ? base0 + (size_t)row * D : base1 + (size_t)(row - S0) * D) + col0;
                const size_t off = (size_t)row * D + col0; float ss = 0.f;
#pragma unroll
                for (int bj = 0; bj < 2; ++bj)
#pragma unroll
                    for (int n = 0; n < 2; ++n) {
                        const int c = bj * 128 + n * 16;
                        const f32x4 v = *(const f32x4*)(bp + c) + acc[ai][bj][m][n] * scale + bv[bj][n];
                        *(f32x4*)(out + off + c) = v;
                        u32x2 w; w.x = pk2(v[0], v[1]); w.y = pk2(v[2], v[3]); *(u32x2*)(xb + off + c) = w;
                        ss += (v[0] * v[0] + v[1] * v[1]) + (v[2] * v[2] + v[3] * v[3]);
                    }
                ss += __shfl_xor(ss, 16); ss += __shfl_xor(ss, 32);
                if (fq == 0) ssq[(size_t)row * 16 + u.pn * 4 + wc] = ss;
                asm volatile("" ::: "memory");
            }
    }
};
struct EpiLruIn {
    static constexpr bool PERM = true, AFTER_DRAIN = false;
    u16* yb; u16* ub; const float* ssq; const float* bias;
    DI void operator()(const f32x4 (&acc)[2][2][4][2], const Unit& u, int wr, int wc, int fr, int fq) const {
        const int row0 = u.pm * 256 + wr * 64 + fr, colg = u.pn * 256 + wc * 32 + fq * 8;
        const bool isy = u.pn < 4; u16* dst = isy ? yb : ub; const int cb = (u.pn & 3) * 256 + wc * 32 + fq * 8;
#pragma unroll
        for (int ai = 0; ai < 2; ++ai)
#pragma unroll
            for (int m = 0; m < 4; ++m) {
                const int row = row0 + ai * 128 + m * 16; const float rs = row_rstd(ssq, row);
#pragma unroll
                for (int bj = 0; bj < 2; ++bj) {
                    u32x4 w;
#pragma unroll
                    for (int n = 0; n < 2; ++n) {
                        f32x4 v = acc[ai][bj][m][n] * rs + *(const f32x4*)(bias + colg + bj * 128 + n * 4);
                        if (isy) {
#pragma unroll
                            for (int e = 0; e < 4; ++e) { const float x = v[e]; v[e] = x * sigm(1.5957691216f * (x + 0.044715f * x * x * x)); }
                        }
                        w[2 * n] = pk2(v[0], v[1]); w[2 * n + 1] = pk2(v[2], v[3]);
                    }
                    *(u32x4*)(dst + (size_t)row * D + cb + bj * 128) = w;
                }
                asm volatile("" ::: "memory");
            }
    }
};
struct EpiQKV {
    static constexpr bool PERM = true, AFTER_DRAIN = false;
    u16* qb; u16* kb; u16* vt; float* nrm; const float* ssq; const float* qgain; const float* kgain; const float* rope;
    DI void operator()(const f32x4 (&acc)[2][2][4][2], const Unit& u, int wr, int wc, int fr, int fq) const {
        const int g = u.pn / 3, t = u.pn - 3 * g, hh = wc >> 1, dlo = 32 * (wc & 1) + 8 * fq;
        const int row0 = u.pm * 256 + wr * 64 + fr;
        if (t < 2) {
            const float* gain = (t == 0 ? qgain : kgain) + g * 128;
            u16* dst = (t == 0 ? qb : kb) + (size_t)(g * 2 + hh) * M * 128;
            float* nr = nrm + (size_t)(g * 2 + t) * M * 4;
#pragma unroll
            for (int ai = 0; ai < 2; ++ai)
#pragma unroll
                for (int m = 0; m < 4; ++m) {
                    const int row = row0 + ai * 128 + m * 16; const float rs = row_rstd(ssq, row);
                    const int pos = row < S0 ? row : ((row - S0) & (S1 - 1));
                    const f32x4* rp = (const f32x4*)(rope + ((size_t)pos * 64 + dlo) * 2);
                    float ss = 0.f; u32x4 wlo, whi;
#pragma unroll
                    for (int n = 0; n < 2; ++n) {
                        f32x4 lo = acc[ai][0][m][n] * rs, hi = acc[ai][1][m][n] * rs;
                        ss += (lo[0] * lo[0] + lo[1] * lo[1]) + (lo[2] * lo[2] + lo[3] * lo[3]) + (hi[0] * hi[0] + hi[1] * hi[1]) + (hi[2] * hi[2] + hi[3] * hi[3]);
                        lo *= *(const f32x4*)(gain + dlo + 4 * n); hi *= *(const f32x4*)(gain + 64 + dlo + 4 * n);
                        const f32x4 c0 = rp[2 * n], c1 = rp[2 * n + 1];
                        const f32x4 cs = {c0[0], c0[2], c1[0], c1[2]}, sn = {c0[1], c0[3], c1[1], c1[3]};
                        const f32x4 olo = lo * cs - hi * sn, ohi = hi * cs + lo * sn;
                        wlo[2 * n] = pk2(olo[0], olo[1]); wlo[2 * n + 1] = pk2(olo[2], olo[3]);
                        whi[2 * n] = pk2(ohi[0], ohi[1]); whi[2 * n + 1] = pk2(ohi[2], ohi[3]);
                    }
                    *(u32x4*)(dst + (size_t)row * 128 + dlo) = wlo;
                    *(u32x4*)(dst + (size_t)row * 128 + 64 + dlo) = whi;
                    ss += __shfl_xor(ss, 16); ss += __shfl_xor(ss, 32);
                    if (fq == 0) nr[(size_t)row * 4 + hh * 2 + (wc & 1)] = ss;
                    asm volatile("" ::: "memory");
                }
        } else {
            u16* vbase = vt + (size_t)(g * 2 + hh) * (M / 16) * 2048;
#pragma unroll
            for (int ai = 0; ai < 2; ++ai)
#pragma unroll
                for (int m = 0; m < 4; ++m) {
                    const int row = row0 + ai * 128 + m * 16; const float rs = row_rstd(ssq, row);
                    int tokp = row;
                    if (g == 1) { const int f = row & 15; tokp = (row & ~15) + (f & 3) * 4 + (f >> 2); }
                    if (g == 2) { const int f = row & 63; tokp = (row & ~63) + (f & 15) * 4 + (f >> 4); }
                    u16* vp = vbase + (size_t)(tokp >> 4) * 2048 + (tokp & 15);
#pragma unroll
                    for (int bj = 0; bj < 2; ++bj)
#pragma unroll
                        for (int n = 0; n < 2; ++n) {
                            const f32x4 v = acc[ai][bj][m][n] * rs; const int dim = 64 * bj + dlo + 4 * n;
                            const unsigned w0 = pk2(v[0], v[1]), w1 = pk2(v[2], v[3]);
                            vp[(dim + 0) * 16] = (u16)(w0 & 0xffffu); vp[(dim + 1) * 16] = (u16)(w0 >> 16);
                            vp[(dim + 2) * 16] = (u16)(w1 & 0xffffu); vp[(dim + 3) * 16] = (u16)(w1 >> 16);
                        }
                    asm volatile("" ::: "memory");
                }
        }
    }
};

DI int cvt_srccol(int mode, int n0) {
    if (mode == 1) { const int pn = n0 >> 8, c = n0 & 255; return c < 128 ? 128 * pn + c : FF + 128 * pn + (c - 128); }
    if (mode == 2) { const int p = n0 / 2304, rem = n0 - p * 2304, pn = rem >> 8, c = rem & 255, g = pn / 3, t = pn - 3 * g, hh = (c & 127) >> 6, db = 64 * (c >> 7); return g * 3072 + t * 1024 + (2 * p + hh) * 128 + db; }
    return n0;
}
DI void cvt_job(LAS float* tile, const float* src, int ld, int K, int Nrows, int mode, const float* gk, u16* dst, int start, int stride) {
    const int tid = opaque_tid(), kt_n = K >> 6, items = (Nrows >> 6) * kt_n;
    for (int it = start; it < items; it += stride) {
        const int nt = it / kt_n, kt = it - nt * kt_n, n0 = nt * 64, k0 = kt * 64, c0 = cvt_srccol(mode, n0);
        const int col = tid & 63, kr = tid >> 6;
#pragma unroll
        for (int i = 0; i < 8; ++i) { const int k = kr + 8 * i; float v = src[(size_t)(k0 + k) * ld + c0 + col]; if (gk) v *= gk[k0 + k]; tile[k * 65 + col] = v; }
        __syncthreads();
        const int r = tid >> 3, kc = (tid & 7) * 8; u32x4 w;
#pragma unroll
        for (int j = 0; j < 4; ++j) w[j] = pk2(tile[(kc + 2 * j) * 65 + r], tile[(kc + 2 * j + 1) * 65 + r]);
        *(u32x4*)(dst + (size_t)(n0 + r) * K + k0 + kc) = w;
        __syncthreads();
    }
}
DI void convert_weights(LAS float* tile, const Params& p, int layer) {
    u16* W = (u16*)p.ws; const int G = gridDim.x, b = blockIdx.x;
    const float* ng = p.in[2] + (size_t)layer * 3 * D;
    for (int f = 0; f < 2; ++f) {
        cvt_job(tile, p.in[3] + (size_t)(layer * 2 + f) * D * 2 * FF, 2 * FF, D, 2 * FF, 1, ng + (f == 0 ? 0 : 2 * D), (u16*)(p.ws + (f == 0 ? W_FI0 : W_FI1)), b, G);
        cvt_job(tile, p.in[4] + (size_t)(layer * 2 + f) * FF * D, D, FF, D, 0, nullptr, (u16*)(p.ws + (f == 0 ? W_FO0 : W_FO1)), (b + 64) % G, G);
    }
    if (layer == 0) {
        cvt_job(tile, p.in[5], 2 * D, D, 2 * D, 0, ng + D, (u16*)(p.ws + W_LRUIN), (b + 128) % G, G);
        for (int q = b; q < 32; q += G) cvt_job(tile, p.in[9] + (size_t)q * 16384, 128, 128, 128, 0, nullptr, (u16*)(p.ws + W_GATE) + (size_t)q * 16384, 0, 1);
        cvt_job(tile, p.in[12], D, D, D, 0, nullptr, (u16*)(p.ws + W_LRUOUT), (b + 192) % G, G);
    } else {
        cvt_job(tile, p.in[14], 9216, D, 9216, 2, ng + D, (u16*)(p.ws + W_QKV), (b + 128) % G, G);
        cvt_job(tile, p.in[17], D, D, D, 0, nullptr, (u16*)(p.ws + W_WO), (b + 192) % G, G);
    }
    (void)W;
}
DI void prologue_x(const Params& p) {
    const int tid = opaque_tid(), lane = tid & 63, wave = tid >> 6;
    u16* xb = (u16*)(p.ws + WS_XB); float* ssq = (float*)(p.ws + WS_SSQ);
    for (int row = blockIdx.x * 8 + wave; row < M; row += gridDim.x * 8) {
        const float* src = row < S0 ? p.in[0] + (size_t)row * D : p.in[1] + (size_t)(row - S0) * D; float ss = 0.f;
#pragma unroll
        for (int i = 0; i < 4; ++i) { const f32x4 v = *(const f32x4*)(src + i * 256 + lane * 4); ss += (v[0] * v[0] + v[1] * v[1]) + (v[2] * v[2] + v[3] * v[3]);
            u32x2 w; w.x = pk2(v[0], v[1]); w.y = pk2(v[2], v[3]); *(u32x2*)(xb + (size_t)row * D + i * 256 + lane * 4) = w; }
#pragma unroll
        for (int o = 32; o >= 1; o >>= 1) ss += __shfl_xor(ss, o);
        if (lane < 16) ssq[(size_t)row * 16 + lane] = lane == 0 ? ss : 0.f;
    }
    f32x2v* tab = (f32x2v*)(p.ws + WS_ROPE);
    for (int idx = blockIdx.x * 512 + tid; idx < S0 * 64; idx += gridDim.x * 512) {
        const int pos = idx >> 6, i = idx & 63;
        const float e = -2.0f * (float)i / 128.0f; const float inv = (float)exp2((double)e * 13.287712379549449);
        const float ang = (float)pos * inv; const double a = (double)ang, nn = rint(a * 0.15915494309189535); const float rf = (float)(a - nn * 6.283185307179586);
        tab[idx] = (f32x2v){cosf(rf), sinf(rf)};
    }
}

constexpr int LT_STRIDE = 272, LT_ROWS = 128, HF_OFF = LT_ROWS * LT_STRIDE, HF_STRIDE = 132, NCHUNK = M / LT_ROWS;
template <int DIR>
DI void lru_dir(LAS unsigned char* lds, const u16* wg, const float* gate_b, const float* lam, int n, int wave, int fr, int fq, int row0, int ch,
                u16* yb, u16* pyo, float* sumA, float* sumB, int tt) {
    LAS const unsigned char* tile = lds; LAS float* hfl = (LAS float*)(lds + HF_OFF);
    const int j = wave * 16 + fr;
    bf16x8 Bf[2][4];
#pragma unroll
    for (int gg = 0; gg < 2; ++gg)
#pragma unroll
        for (int ks = 0; ks < 4; ++ks) Bf[gg][ks] = *(const bf16x8*)(wg + ((size_t)((DIR * 2 + gg) * 8 + n) * 128 + j) * 128 + 32 * ks + 8 * fq);
    const float gbr = gate_b[((DIR * 2 + 0) * 8 + n) * 128 + j], gbi = gate_b[((DIR * 2 + 1) * 8 + n) * 128 + j];
    const float nl = -lam[DIR * D + ch]; const float c8 = 8.0f * (fmaxf(nl, 0.f) + log1pf(expf(-fabsf(nl))));
    float Arun = 1.f, Brun = 0.f;
    const int oq = DIR ? 3 - fq : fq; const int lane = fq * 16 + fr;
    const int p16 = DIR ? lane + 16 : lane - 16, p32 = DIR ? lane + 32 : lane - 32, ptot = DIR ? fr : fr + 48;
#pragma unroll 1
    for (int it = 0; it < LT_ROWS / 16; ++it) {
        const int mt = DIR ? LT_ROWS / 16 - 1 - it : it;
        f32x4 dr = {0.f, 0.f, 0.f, 0.f}, di = {0.f, 0.f, 0.f, 0.f};
#pragma unroll
        for (int ks = 0; ks < 4; ++ks) {
            const bf16x8 a = *(LAS const bf16x8*)(tile + (16 * mt + fr) * LT_STRIDE + (32 * ks + 8 * fq) * 2);
            dr = __builtin_amdgcn_mfma_f32_16x16x32_bf16(a, Bf[0][ks], dr, 0, 0, 0);
            di = __builtin_amdgcn_mfma_f32_16x16x32_bf16(a, Bf[1][ks], di, 0, 0, 0);
        }
        float av[4], bv[4];
#pragma unroll
        for (int r = 0; r < 4; ++r) {
            const int tok = 16 * mt + 4 * fq + r;
            const float uc = bf2f(*(LAS const u16*)(tile + tok * LT_STRIDE + j * 2));
            const float rg = sigm(dr[r] + gbr), ig = sigm(di[r] + gbi);
            const float a = __expf(-c8 * rg);
            av[r] = a; bv[r] = __builtin_sqrtf(fmaxf(1.0f - a * a, 0.f)) * ig * uc;
        }
        float Ap[4], Bp[4];
#pragma unroll
        for (int q = 0; q < 4; ++q) { const int r = DIR ? 3 - q : q; if (q == 0) { Ap[0] = av[r]; Bp[0] = bv[r]; } else { Ap[q] = av[r] * Ap[q - 1]; Bp[q] = av[r] * Bp[q - 1] + bv[r]; } }
        float Ai = Ap[3], Bi = Bp[3];
        { const float pa = __shfl(Ai, p16), pb = __shfl(Bi, p16); if (oq >= 1) { Bi = Ai * pb + Bi; Ai = Ai * pa; } }
        { const float pa = __shfl(Ai, p32), pb = __shfl(Bi, p32); if (oq >= 2) { Bi = Ai * pb + Bi; Ai = Ai * pa; } }
        float ea = __shfl(Ai, p16), eb = __shfl(Bi, p16); if (oq == 0) { ea = 1.f; eb = 0.f; }
        const float ta = __shfl(Ai, ptot), tb = __shfl(Bi, ptot);
        const float Ax = ea * Arun, Bx = ea * Brun + eb;
#pragma unroll
        for (int q = 0; q < 4; ++q) {
            const int r = DIR ? 3 - q : q; const float h = Ap[q] * Bx + Bp[q], P = Ap[q] * Ax;
            const int tok = 16 * mt + 4 * fq + r;
            const size_t off = (size_t)(row0 + tok) * D + ch;
            const float y = bf2f(yb[off]);
            if (DIR == 0) { hfl[tok * HF_STRIDE + j] = h; pyo[off] = (u16)(pk2(P * y, 0.f) & 0xffffu); }
            else { yb[off] = (u16)(pk2((hfl[tok * HF_STRIDE + j] + h) * y, 0.f) & 0xffffu); pyo[off] = (u16)(pk2(P * y, 0.f) & 0xffffu); }
        }
        Brun = ta * Brun + tb; Arun = ta * Arun;
    }
    if (fq == 0) { sumA[(size_t)(DIR * NCHUNK + tt) * D + ch] = Arun; sumB[(size_t)(DIR * NCHUNK + tt) * D + ch] = Brun; }
}
DI void lru_l1(LAS unsigned char* lds, const Params& p) {
    const int tid = opaque_tid(), lane = tid & 63, wave = tid >> 6, fr = lane & 15, fq = lane >> 4;
    const u16* ub = (const u16*)(p.ws + WS_UB); u16* yb = (u16*)(p.ws + WS_YB); u16* pyf = (u16*)(p.ws + WS_PYF); u16* pyb = (u16*)(p.ws + WS_PYB);
    const u16* wg = (const u16*)(p.ws + W_GATE); float* sumA = (float*)(p.ws + WS_SUMA); float* sumB = (float*)(p.ws + WS_SUMB);
    const float* conv_w = p.in[7]; const float* conv_b = p.in[8];
    for (int unit = blockIdx.x; unit < NCHUNK * 8; unit += gridDim.x) {
        const int tt = unit >> 3, n = unit & 7, row0 = tt * LT_ROWS;
        const int sbase = row0 < S0 ? 0 : S0 + ((row0 - S0) & ~(S1 - 1)), send = sbase + (row0 < S0 ? S0 : S1);
        {
            const int c = tid & 15, ch8 = n * 128 + c * 8;
            float w[4][8], cb[8];
#pragma unroll
            for (int k = 0; k < 4; ++k) { const f32x4 a = *(const f32x4*)(conv_w + k * D + ch8), b = *(const f32x4*)(conv_w + k * D + ch8 + 4);
#pragma unroll
                for (int e = 0; e < 4; ++e) { w[k][e] = a[e]; w[k][4 + e] = b[e]; } }
            { const f32x4 a = *(const f32x4*)(conv_b + ch8), b = *(const f32x4*)(conv_b + ch8 + 4);
#pragma unroll
                for (int e = 0; e < 4; ++e) { cb[e] = a[e]; cb[4 + e] = b[e]; } }
#pragma unroll 1
            for (int i = 0; i < LT_ROWS / 32; ++i) {
                const int r = (tid >> 4) + 32 * i, row = row0 + r; float acc[8];
#pragma unroll
                for (int e = 0; e < 8; ++e) acc[e] = cb[e];
#pragma unroll
                for (int k = 0; k < 4; ++k) { const int rr = row + k - 2;
                    if (rr >= sbase && rr < send) { const u32x4 v = *(const u32x4*)(ub + (size_t)rr * D + ch8);
#pragma unroll
                        for (int e = 0; e < 4; ++e) { acc[2 * e] += w[k][2 * e] * bf2f(v[e] & 0xffffu); acc[2 * e + 1] += w[k][2 * e + 1] * bf2f(v[e] >> 16); } } }
                u32x4 o;
#pragma unroll
                for (int e = 0; e < 4; ++e) o[e] = pk2(acc[2 * e], acc[2 * e + 1]);
                *(LAS u32x4*)(lds + r * LT_STRIDE + c * 16) = o;
            }
        }
        __syncthreads();
        {
            const int ch = n * 128 + wave * 16 + fr;
            lru_dir<0>(lds, wg, p.in[10], p.in[11], n, wave, fr, fq, row0, ch, yb, pyf, sumA, sumB, tt);
            lru_dir<1>(lds, wg, p.in[10], p.in[11], n, wave, fr, fq, row0, ch, yb, pyb, sumA, sumB, tt);
        }
        __syncthreads();
    }
}
DI void lru_carry(const Params& p) {
    const float* sumA = (const float*)(p.ws + WS_SUMA); const float* sumB = (const float*)(p.ws + WS_SUMB);
    float* cF = (float*)(p.ws + WS_CF); float* cB = (float*)(p.ws + WS_CB);
    const int gt = blockIdx.x * 512 + opaque_tid();
    if (gt < 9 * 2 * D) {
        const int ch = gt & (D - 1), d = (gt >> 10) & 1, s = gt >> 11;
        const int t0 = s == 0 ? 0 : 128 + 16 * (s - 1), nt = s == 0 ? 128 : 16; float c = 0.f;
        if (d == 0) {
#pragma unroll 8
            for (int k = 0; k < nt; ++k) { const int tt = t0 + k; cF[(size_t)tt * D + ch] = c; c = sumA[(size_t)tt * D + ch] * c + sumB[(size_t)tt * D + ch]; }
        } else {
#pragma unroll 8
            for (int k = nt - 1; k >= 0; --k) { const int tt = t0 + k; cB[(size_t)tt * D + ch] = c; c = sumA[(size_t)(NCHUNK + tt) * D + ch] * c + sumB[(size_t)(NCHUNK + tt) * D + ch]; }
        }
    }
}
DI void lru_l3(const Params& p) {
    u16* yb = (u16*)(p.ws + WS_YB); const u16* pyf = (const u16*)(p.ws + WS_PYF); const u16* pyb = (const u16*)(p.ws + WS_PYB);
    const float* cF = (const float*)(p.ws + WS_CF); const float* cB = (const float*)(p.ws + WS_CB);
    for (int idx = blockIdx.x * 512 + opaque_tid(); idx < M * 128; idx += gridDim.x * 512) {
        const int row = idx >> 7, c8 = (idx & 127) * 8, tt = row >> 7; const size_t off = (size_t)row * D + c8;
        const u32x4 h = *(const u32x4*)(yb + off), f = *(const u32x4*)(pyf + off), b = *(const u32x4*)(pyb + off);
        const f32x4 f0 = *(const f32x4*)(cF + (size_t)tt * D + c8), f1 = *(const f32x4*)(cF + (size_t)tt * D + c8 + 4);
        const f32x4 b0 = *(const f32x4*)(cB + (size_t)tt * D + c8), b1 = *(const f32x4*)(cB + (size_t)tt * D + c8 + 4);
        u32x4 o;
#pragma unroll
        for (int e = 0; e < 4; ++e) {
            const float cf0 = e < 2 ? f0[2 * e] : f1[2 * e - 4], cf1 = e < 2 ? f0[2 * e + 1] : f1[2 * e - 3];
            const float cb0 = e < 2 ? b0[2 * e] : b1[2 * e - 4], cb1 = e < 2 ? b0[2 * e + 1] : b1[2 * e - 3];
            const float v0 = bf2f(h[e] & 0xffffu) + bf2f(f[e] & 0xffffu) * cf0 + bf2f(b[e] & 0xffffu) * cb0;
            const float v1 = bf2f(h[e] >> 16) + bf2f(f[e] >> 16) * cf1 + bf2f(b[e] >> 16) * cb1;
            o[e] = pk2(v0, v1);
        }
        *(u32x4*)(yb + off) = o;
    }
}

DI void attn_phase(const Params& p) {
    const int tid = opaque_tid(), lane = tid & 63, wave = tid >> 6, fr = lane & 15, fq = lane >> 4;
    u16* qbuf = (u16*)(p.ws + WS_Q); const u16* kbuf = (const u16*)(p.ws + WS_K); const u16* vtb = (const u16*)(p.ws + WS_VT);
    const float* nrm = (const float*)(p.ws + WS_NRM); float* lse = (float*)(p.ws + WS_LSE);
    const int NW = gridDim.x * 8, wg = blockIdx.x * 8 + wave;
    for (int unit = wg; unit < 6 * 1024; unit += NW) {
        const int gh = unit >> 10, bidx = unit & 1023, g = gh >> 1, hh = gh & 1, dsh = 2 * g;
        const int row0 = bidx * 32;
        const int sbase = row0 < S0 ? 0 : S0 + ((row0 - S0) & ~(S1 - 1)), S = row0 < S0 ? S0 : S1;
        const int L = S >> dsh, bpr = L >> 5, lb = (row0 - sbase) >> 5, rho = lb / bpr, q0 = (lb - rho * bpr) * 32;
        u16* Q = qbuf + (size_t)gh * M * 128; const u16* K = kbuf + (size_t)gh * M * 128; const u16* Vt = vtb + (size_t)gh * (M / 16) * 2048;
        const float* nq = nrm + (size_t)(g * 2 + 0) * M * 4 + hh * 2; const float* nk = nrm + (size_t)(g * 2 + 1) * M * 4 + hh * 2;
        bf16x8 Qf[2][4]; float sq[2]; int qrow[2];
#pragma unroll
        for (int qt = 0; qt < 2; ++qt) {
            qrow[qt] = sbase + ((q0 + 16 * qt + fr) << dsh) + rho;
#pragma unroll
            for (int ks = 0; ks < 4; ++ks) Qf[qt][ks] = *(const bf16x8*)(Q + (size_t)qrow[qt] * 128 + 32 * ks + 8 * fq);
            const f32x2v pq = *(const f32x2v*)(nq + (size_t)qrow[qt] * 4);
            sq[qt] = __builtin_amdgcn_rsqf((pq.x + pq.y) * (1.0f / 128.0f) + 1e-6f) * 0.08838834764831845f;
        }
        f32x4 Sc[10][2];
#pragma unroll
        for (int T = 0; T < 10; ++T) {
            const int kidx0 = q0 - 64 + 16 * T;
            const int kc = min(max(kidx0 + fr, 0), L - 1); const size_t krow = (size_t)(sbase + (kc << dsh) + rho);
            bf16x8 Kf[4];
#pragma unroll
            for (int ks = 0; ks < 4; ++ks) Kf[ks] = *(const bf16x8*)(K + krow * 128 + 32 * ks + 8 * fq);
            float rk[4]; bool inb[4];
#pragma unroll
            for (int r = 0; r < 4; ++r) {
                const int kk = kidx0 + 4 * fq + r; inb[r] = (kk >= 0) && (kk < L);
                const int kkc = min(max(kk, 0), L - 1);
                const f32x2v pk = *(const f32x2v*)(nk + (size_t)(sbase + (kkc << dsh) + rho) * 4);
                rk[r] = __builtin_amdgcn_rsqf((pk.x + pk.y) * (1.0f / 128.0f) + 1e-6f);
            }
#pragma unroll
            for (int qt = 0; qt < 2; ++qt) {
                f32x4 acc = {0.f, 0.f, 0.f, 0.f};
#pragma unroll
                for (int ks = 0; ks < 4; ++ks) acc = __builtin_amdgcn_mfma_f32_16x16x32_bf16(Kf[ks], Qf[qt][ks], acc, 0, 0, 0);
                const int qi = q0 + 16 * qt + fr;
#pragma unroll
                for (int r = 0; r < 4; ++r) {
                    const int kk = kidx0 + 4 * fq + r; const int dd = kk - qi;
                    const bool ok = inb[r] && dd <= 64 && dd >= -64;
                    Sc[T][qt][r] = ok ? acc[r] * sq[qt] * rk[r] : -1e30f;
                }
            }
            if (T & 1) { asm volatile("" ::: "memory"); __builtin_amdgcn_sched_barrier(0); }
        }
        float linv[2], lsev[2];
#pragma unroll
        for (int qt = 0; qt < 2; ++qt) {
            float mx = -1e30f;
#pragma unroll
            for (int T = 0; T < 10; ++T)
#pragma unroll
                for (int r = 0; r < 4; ++r) mx = fmaxf(mx, Sc[T][qt][r]);
            mx = fmaxf(mx, __shfl_xor(mx, 16)); mx = fmaxf(mx, __shfl_xor(mx, 32));
            float sum = 0.f;
#pragma unroll
            for (int T = 0; T < 10; ++T)
#pragma unroll
                for (int r = 0; r < 4; ++r) { const float e = __expf(Sc[T][qt][r] - mx); Sc[T][qt][r] = e; sum += e; }
            sum += __shfl_xor(sum, 16); sum += __shfl_xor(sum, 32);
            linv[qt] = 1.0f / sum; lsev[qt] = mx + __logf(sum);
        }
        f32x4 O[8][2];
#pragma unroll
        for (int dt = 0; dt < 8; ++dt)
#pragma unroll
            for (int qt = 0; qt < 2; ++qt) O[dt][qt] = (f32x4){0.f, 0.f, 0.f, 0.f};
#pragma unroll
        for (int tp = 0; tp < 5; ++tp) {
            bf16x8 Pf[2];
#pragma unroll
            for (int qt = 0; qt < 2; ++qt) {
                u32x4 w; w[0] = pk2(Sc[2 * tp][qt][0], Sc[2 * tp][qt][1]); w[1] = pk2(Sc[2 * tp][qt][2], Sc[2 * tp][qt][3]);
                w[2] = pk2(Sc[2 * tp + 1][qt][0], Sc[2 * tp + 1][qt][1]); w[3] = pk2(Sc[2 * tp + 1][qt][2], Sc[2 * tp + 1][qt][3]);
                Pf[qt] = __builtin_bit_cast(bf16x8, w);
            }
            const int ka = q0 - 64 + 32 * tp + 4 * fq, kb2 = ka + 16;
            const int kac = min(max(ka, 0), L - 4), kbc = min(max(kb2, 0), L - 4);
            const int tpa = sbase + (((kac >> 2) * 4) << dsh) + (g ? 4 * rho : 0), tpb = sbase + (((kbc >> 2) * 4) << dsh) + (g ? 4 * rho : 0);
            const u16* va = Vt + (size_t)(tpa >> 4) * 2048 + (tpa & 15); const u16* vb = Vt + (size_t)(tpb >> 4) * 2048 + (tpb & 15);
#pragma unroll
            for (int dt = 0; dt < 8; ++dt) {
                const int dim = 16 * dt + fr;
                const u32x2 a = *(const u32x2*)(va + dim * 16), b = *(const u32x2*)(vb + dim * 16);
                const u32x4 w = {a.x, a.y, b.x, b.y}; const bf16x8 Vf = __builtin_bit_cast(bf16x8, w);
#pragma unroll
                for (int qt = 0; qt < 2; ++qt) O[dt][qt] = __builtin_amdgcn_mfma_f32_16x16x32_bf16(Vf, Pf[qt], O[dt][qt], 0, 0, 0);
            }
            asm volatile("" ::: "memory"); __builtin_amdgcn_sched_barrier(0);
        }
#pragma unroll
        for (int qt = 0; qt < 2; ++qt) {
#pragma unroll
            for (int dt = 0; dt < 8; ++dt) {
                const f32x4 o = O[dt][qt] * linv[qt]; u32x2 w; w.x = pk2(o[0], o[1]); w.y = pk2(o[2], o[3]);
                *(u32x2*)(Q + (size_t)qrow[qt] * 128 + 16 * dt + 4 * fq) = w;
            }
            if (fq == 0) lse[(size_t)gh * M + qrow[qt]] = lsev[qt];
        }
    }
}
DI void attn_merge(const Params& p, int pass) {
    const u16* qbuf = (const u16*)(p.ws + WS_Q); const float* lse = (const float*)(p.ws + WS_LSE); u16* ao = (u16*)(p.ws + WS_AO);
    for (int idx = blockIdx.x * 512 + opaque_tid(); idx < M * 32; idx += gridDim.x * 512) {
        const int c = idx & 15, hh = (idx >> 4) & 1, row = idx >> 5;
        const float l0 = lse[(size_t)(0 + hh) * M + row], l1 = lse[(size_t)(2 + hh) * M + row], l2 = lse[(size_t)(4 + hh) * M + row];
        const float mx = fmaxf(l0, fmaxf(l1, l2)); float w0 = __expf(l0 - mx), w1 = __expf(l1 - mx), w2 = __expf(l2 - mx);
        const float inv = 1.0f / (w0 + w1 + w2); w0 *= inv; w1 *= inv; w2 *= inv;
        const u32x4 a = *(const u32x4*)(qbuf + ((size_t)(0 + hh) * M + row) * 128 + 8 * c), b = *(const u32x4*)(qbuf + ((size_t)(2 + hh) * M + row) * 128 + 8 * c),
                    d = *(const u32x4*)(qbuf + ((size_t)(4 + hh) * M + row) * 128 + 8 * c);
        u32x4 o;
#pragma unroll
        for (int e = 0; e < 4; ++e) {
            const float v0 = w0 * bf2f(a[e] & 0xffffu) + w1 * bf2f(b[e] & 0xffffu) + w2 * bf2f(d[e] & 0xffffu);
            const float v1 = w0 * bf2f(a[e] >> 16) + w1 * bf2f(b[e] >> 16) + w2 * bf2f(d[e] >> 16);
            o[e] = pk2(v0, v1);
        }
        *(u32x4*)(ao + (size_t)row * D + (2 * pass + hh) * 128 + 8 * c) = o;
    }
}

enum { K_PRO = 0, K_FFN1, K_RESID, K_LRUIN, K_L1, K_CARRY, K_L3, K_QKV, K_ATTN, K_MERGE };
__global__ void __launch_bounds__(512, 2) mega(Params p) {
    extern __shared__ __attribute__((aligned(16))) unsigned char lds_raw[];
    LAS unsigned char* lds = (LAS unsigned char*)lds_raw;
    cg::grid_group grid = cg::this_grid();
    unsigned char* ws = p.ws;
    u16* xb = (u16*)(ws + WS_XB); float* ssq = (float*)(ws + WS_SSQ);
#ifndef ONLY_KIND
    prologue_x(p);
#endif
#pragma unroll 1
    for (int ph = 0; ph < NPHASE; ++ph) {
        int kind, a0 = 0, a1 = 0;
        if (ph == 0) { kind = K_PRO; a0 = 0; }
        else if (ph == 1) { kind = K_FFN1; a0 = 0; a1 = 0; }
        else if (ph == 2) { kind = K_RESID; a0 = 0; a1 = 0; }
        else if (ph == 3) kind = K_LRUIN;
        else if (ph == 4) kind = K_L1;
        else if (ph == 5) kind = K_CARRY;
        else if (ph == 6) kind = K_L3;
        else if (ph == 7) { kind = K_RESID; a1 = 2; }
        else if (ph == 8) { kind = K_FFN1; a0 = 0; a1 = 1; }
        else if (ph == 9) { kind = K_RESID; a0 = 0; a1 = 1; }
        else if (ph == 10) { kind = K_PRO; a0 = 1; }
        else if (ph == 11) { kind = K_FFN1; a0 = 1; a1 = 0; }
        else if (ph == 12) { kind = K_RESID; a0 = 1; a1 = 0; }
        else if (ph <= 24) { const int q = ph - 13; a0 = q / 3; const int s = q - 3 * a0; kind = s == 0 ? K_QKV : (s == 1 ? K_ATTN : K_MERGE); }
        else if (ph == 25) { kind = K_RESID; a1 = 3; }
        else if (ph == 26) { kind = K_FFN1; a0 = 1; a1 = 1; }
        else { kind = K_RESID; a0 = 1; a1 = 1; }

#ifdef ONLY_KIND
        if (kind != ONLY_KIND) continue;
#endif
        switch (kind) {
        case K_PRO: {
            convert_weights((LAS float*)lds, p, a0);
        } break;
        case K_FFN1: {
            pg8::Gemm g{xb, (const u16*)(ws + (a1 == 0 ? W_FI0 : W_FI1)), M, 2 * FF, D}; pg8::StaticOrder S; S.init(M, 2 * FF, (int)gridDim.x, (int)blockIdx.x);
            EpiFFN1 E{(u16*)(ws + WS_HID), ssq};
            pg8::gemm_phase<EpiFFN1, pg8::StaticOrder, false>(lds, g, S, E, nullptr);
        } break;
        case K_RESID: {
            pg8::Gemm g; EpiResid E; E.out = p.out; E.xb = xb; E.ssq = ssq; E.base0 = p.out; E.base1 = p.out + (size_t)S0 * D; E.bias = nullptr; E.scale = 1.0f;
            if (a1 < 2) { g = pg8::Gemm{(const u16*)(ws + WS_HID), (const u16*)(ws + (a1 == 0 ? W_FO0 : W_FO1)), M, D, FF}; E.scale = 0.5f;
                          if (a0 == 0 && a1 == 0) { E.base0 = p.in[0]; E.base1 = p.in[1]; } }
            else if (a1 == 2) { g = pg8::Gemm{(const u16*)(ws + WS_YB), (const u16*)(ws + W_LRUOUT), M, D, D}; E.bias = p.in[13]; }
            else { g = pg8::Gemm{(const u16*)(ws + WS_AO), (const u16*)(ws + W_WO), M, D, D}; }
            pg8::StaticOrder S; S.init(M, D, (int)gridDim.x, (int)blockIdx.x);
            pg8::gemm_phase<EpiResid, pg8::StaticOrder, false>(lds, g, S, E, nullptr);
        } break;
        case K_LRUIN: {
            pg8::Gemm g{xb, (const u16*)(ws + W_LRUIN), M, 2 * D, D}; pg8::StaticOrder S; S.init(M, 2 * D, (int)gridDim.x, (int)blockIdx.x);
            EpiLruIn E{(u16*)(ws + WS_YB), (u16*)(ws + WS_UB), ssq, p.in[6]};
            pg8::gemm_phase<EpiLruIn, pg8::StaticOrder, false>(lds, g, S, E, nullptr);
        } break;
        case K_L1: lru_l1(lds, p); break;
        case K_CARRY: lru_carry(p); break;
        case K_L3: lru_l3(p); break;
        case K_QKV: {
            pg8::Gemm g{xb, (const u16*)(ws + W_QKV) + (size_t)a0 * 2304 * D, M, 2304, D}; pg8::StaticOrder S; S.init(M, 2304, (int)gridDim.x, (int)blockIdx.x);
            EpiQKV E{(u16*)(ws + WS_Q), (u16*)(ws + WS_K), (u16*)(ws + WS_VT), (float*)(ws + WS_NRM), ssq, p.in[15], p.in[16], (const float*)(ws + WS_ROPE)};
            pg8::gemm_phase<EpiQKV, pg8::StaticOrder, false>(lds, g, S, E, nullptr);
        } break;
        case K_ATTN: attn_phase(p); break;
        case K_MERGE: attn_merge(p, a0); break;
        }
        if (ph != NPHASE - 1) grid.sync();
    }
}

extern "C" void kernel_launch(void* const* d_in, const int* in_sizes, int n_in, void* d_out, int out_size, void* d_ws, size_t ws_size, hipStream_t stream) {
    static int grid_blocks = 0;
    if (grid_blocks == 0) {
        if (n_in != 18 || out_size != M * D || ws_size < WS_END) { fprintf(stderr, "kernel_launch: unexpected shapes (n_in %d out %d ws %zu need %zu)\n", n_in, out_size, ws_size, (size_t)WS_END); grid_blocks = -1; return; }
        int dev = 0, cus = 0, per_cu = 0;
        hipGetDevice(&dev); hipDeviceGetAttribute(&cus, hipDeviceAttributeMultiprocessorCount, dev);
        if (hipFuncSetAttribute((const void*)mega, hipFuncAttributeMaxDynamicSharedMemorySize, LDS_BYTES) != hipSuccess) { fprintf(stderr, "kernel_launch: hipFuncSetAttribute failed\n"); (void)hipGetLastError(); }
        if (hipOccupancyMaxActiveBlocksPerMultiprocessor(&per_cu, (const void*)mega, 512, LDS_BYTES) != hipSuccess || per_cu < 1) { fprintf(stderr, "kernel_launch: occupancy query says %d\n", per_cu); (void)hipGetLastError(); per_cu = 1; }
        grid_blocks = cus;
    }
    if (grid_blocks < 0) return;
    Params p{};
    for (int i = 0; i < 18; ++i) p.in[i] = (const float*)d_in[i];
    p.out = (float*)d_out; p.ws = (unsigned char*)d_ws;
    void* args[] = {&p};
    hipError_t e = hipLaunchCooperativeKernel((const void*)mega, dim3(grid_blocks), dim3(512), args, LDS_BYTES, stream);
    if (e != hipSuccess) fprintf(stderr, "cooperative launch failed: %s (grid %d)\n", hipGetErrorString(e), grid_blocks);
}
```

```cpp
#include <hip/hip_runtime.h>
#include <hip/hip_cooperative_groups.h>
#include <cstdio>
namespace cg = cooperative_groups;

namespace pg8 {
#define PG8_LAS __attribute__((address_space(3)))
typedef unsigned short bf16_t;
typedef short bf16x8 __attribute__((ext_vector_type(8)));
typedef float f32x4 __attribute__((ext_vector_type(4)));
typedef unsigned u32x4 __attribute__((ext_vector_type(4)));
constexpr int BM = 256, BK = 64, HALF = 128, HTB = HALF * BK * 2  , STAGE_BYTES = 8 * HTB, NXCD = 8, WGM = 8;

__host__ __device__ __forceinline__ int lds_byte(int r, int c) { const int st = (r >> 4) * 2 + (c >> 5), rr = r & 15, cc = c & 31, ob = rr * 64 + cc * 2; return st * 1024 + (ob ^ (((ob >> 9) & 1) << 5)); }
__host__ __device__ __forceinline__ void stage_rc(int b, int& R, int& C) { const int st = b / 1024, sb = b % 1024, swz = sb ^ (((sb >> 9) & 1) << 5); R = (st >> 1) * 16 + swz / 64; C = (st & 1) * 32 + (swz % 64) / 2; }
__host__ __device__ __forceinline__ int perm32(int rho) { const int n = rho >> 4, i = rho & 15; return 8 * (i >> 2) + 4 * n + (i & 3); }

struct Unit { int pm, pn; };
struct Gemm { const bf16_t* A; const bf16_t* Bt; int M, N, K; long long delta; int split; };

struct StaticOrder {
    int nM, nN, nwg, G, c, rev;
    __host__ __device__ void init(int M, int N, int G_, int c_) { nM = M / BM; nN = N / BM; nwg = nM * nN; G = G_; c = c_; rev = 0; }
    __host__ __device__ bool next(int i, Unit& u) const {
        const long L = (long)i * G + c; if (L >= nwg) return false;
        int wgid = rev ? nwg - 1 - (int)L : (int)L; { const int q = nwg / NXCD, r = nwg % NXCD, xcd = wgid % NXCD, off = wgid / NXCD; wgid = (xcd < r ? xcd * (q + 1) : r * (q + 1) + (xcd - r) * q) + off; }
        const int nig = WGM * nN, gid = wgid / nig, fm = gid * WGM, gsz = (nM - fm) < WGM ? (nM - fm) : WGM;
        u.pm = fm + ((wgid % nig) % gsz); u.pn = (wgid % nig) / gsz; return true;
    }
    __device__ __forceinline__ void a_ready(const Unit&) const {}
    __device__ __forceinline__ void done(const Unit&) const {}
};
__device__ __forceinline__ unsigned cvt_pk_bf16(float lo, float hi) { unsigned r; asm volatile("v_cvt_pk_bf16_f32 %0, %1, %2" : "=v"(r) : "v"(lo), "v"(hi)); return r; }
typedef float f32x2 __attribute__((ext_vector_type(2)));
template <class Epi, class Sched, bool STAMP = false>
__device__ __forceinline__ void gemm_phase(PG8_LAS unsigned char* lds, const Gemm g, const Sched& S, const Epi& E, unsigned long long* stamps) {
    int tid_o = threadIdx.x; asm volatile("" : "+v"(tid_o));
    const int tid = tid_o, wid = __builtin_amdgcn_readfirstlane(tid >> 6), lane = tid & 63, wr = wid >> 2, wc = wid & 3, fr = lane & 15, fq = lane >> 4;
    const int K = g.K, nt = K / BK;
    int ts_lo = 0, ts_hi = 0, nts = 0; const unsigned long long rt_entry = STAMP ? (unsigned long long)wall_clock64() : 0ull;
#define PG8_STAMP() do { if (STAMP && wid == 0 && nts < 64) { const unsigned long long _c = (unsigned long long)clock64(); \
        ts_lo = (lane == nts) ? (int)(unsigned)_c : ts_lo; ts_hi = (lane == nts) ? (int)(unsigned)(_c >> 32) : ts_hi; ++nts; } } while (0)
    PG8_STAMP();
    unsigned voffA[2], voffB[2];
#pragma unroll
    for (int i = 0; i < 2; ++i) { int R, C; stage_rc(tid * 16 + i * 8192, R, C); const int Rb = Epi::PERM ? ((R & ~31) + perm32(R & 31)) : R;
        voffA[i] = (unsigned)(R * K + C) * 2u; voffB[i] = (unsigned)(Rb * K + C) * 2u; }
    const size_t kstep = (size_t)(BK * 2);
    const size_t hstep = (size_t)HALF * K * 2;
    const size_t tstep = 2 * hstep;
    const unsigned ldsw = (unsigned)wid * 1024u;
    const int aoff = lds_byte(wr * 64 + fr, fq * 8), boff = lds_byte(wc * 32 + fr, fq * 8);
#define PG8_SA(b, h) (((b) * 2 + (h)) * HTB)
#define PG8_SB(b, h) ((4 + (b) * 2 + (h)) * HTB)
#define PG8_STAGE(bufoff, gbase, voff) do { _Pragma("unroll") for (int _i = 0; _i < 2; ++_i) \
        __builtin_amdgcn_global_load_lds((const unsigned*)((const char*)(gbase) + (voff)[_i]), (PG8_LAS unsigned*)(lds + (bufoff) + ldsw + _i * 8192), 16, 0, 0); } while (0)
#define PG8_LDA(dst, b, h) do { _Pragma("unroll") for (int m = 0; m < 4; ++m) _Pragma("unroll") for (int k = 0; k < 2; ++k) dst[m][k] = *(const PG8_LAS bf16x8*)(lds + PG8_SA(b, h) + aoff + m * 2048 + k * 1024); } while (0)
#define PG8_LDB(dst, b, h) do { _Pragma("unroll") for (int n = 0; n < 2; ++n) _Pragma("unroll") for (int k = 0; k < 2; ++k) dst[n][k] = *(const PG8_LAS bf16x8*)(lds + PG8_SB(b, h) + boff + n * 2048 + k * 1024); } while (0)
#define PG8_MMA(ai, bj, At, Bt) do { __builtin_amdgcn_s_setprio(1); _Pragma("unroll") for (int m = 0; m < 4; ++m) _Pragma("unroll") for (int n = 0; n < 2; ++n) _Pragma("unroll") for (int k = 0; k < 2; ++k) \
        acc[ai][bj][m][n] = __builtin_amdgcn_mfma_f32_16x16x32_bf16(Bt[n][k], At[m][k], acc[ai][bj][m][n], 0, 0, 0); __builtin_amdgcn_s_setprio(0); } while (0)
#define PG8_WAIT_V(n) asm volatile("s_waitcnt vmcnt(" #n ")" ::: "memory")
#define PG8_WAIT_L(n) asm volatile("s_waitcnt lgkmcnt(" #n ")" ::: "memory")
#define PG8_BAR __builtin_amdgcn_s_barrier()
#define PG8_SCHED __builtin_amdgcn_sched_barrier(0)
    Unit cur, nxt; int ui = 0;
    if (!S.next(0, cur)) return;
    f32x4 acc[2][2][4][2];
#pragma unroll
    for (int a = 0; a < 2; ++a)
#pragma unroll
        for (int b = 0; b < 2; ++b)
#pragma unroll
            for (int m = 0; m < 4; ++m)
#pragma unroll
                for (int n = 0; n < 2; ++n) acc[a][b][m][n] = (f32x4){0.f, 0.f, 0.f, 0.f};
    bf16x8 At[4][2], B0[2][2], B1[2][2];
    const char* cA = ((const char*)g.A + (size_t)cur.pm * tstep + (cur.pm < g.split ? 0ll : g.delta)); const char* cB = (const char*)g.Bt + (size_t)cur.pn * tstep;
    S.a_ready(cur);
    PG8_STAGE(PG8_SB(0, 0), cB, voffB); PG8_STAGE(PG8_SA(0, 0), cA, voffA); PG8_STAGE(PG8_SB(0, 1), cB + hstep, voffB); PG8_STAGE(PG8_SA(0, 1), cA + hstep, voffA);
    if (wr == 1) PG8_BAR;
    PG8_WAIT_V(4); PG8_BAR;
    PG8_STAGE(PG8_SB(1, 0), cB + kstep, voffB); PG8_STAGE(PG8_SA(1, 0), cA + kstep, voffA); PG8_STAGE(PG8_SB(1, 1), cB + hstep + kstep, voffB);
    PG8_WAIT_V(6); PG8_BAR;
    PG8_STAMP();
    for (;;) {
        const bool has_next = S.next(ui + 1, nxt);
        const char* nA = has_next ? ((const char*)g.A + (size_t)nxt.pm * tstep + (nxt.pm < g.split ? 0ll : g.delta)) : cA; const char* nB = has_next ? (const char*)g.Bt + (size_t)nxt.pn * tstep : cB;
        for (int t = 0; t < nt; t += 2) {
            const bool last = (t == nt - 2);
            const char* a1 = cA + (size_t)(t + 1) * kstep;
            const char* a2 = last ? nA : cA + (size_t)(t + 2) * kstep; const char* b2 = last ? nB : cB + (size_t)(t + 2) * kstep;
            const char* a3 = a2 + kstep; const char* b3 = b2 + kstep;
            if (last && has_next) S.a_ready(nxt);
            PG8_LDB(B0, 0, 0); PG8_SCHED; PG8_LDA(At, 0, 0); PG8_STAGE(PG8_SA(1, 1), a1 + hstep, voffA);
            PG8_WAIT_L(8); PG8_BAR; PG8_WAIT_L(0); PG8_MMA(0, 0, At, B0); PG8_BAR; PG8_SCHED;
            PG8_LDB(B1, 0, 1); PG8_STAGE(PG8_SB(0, 0), b2, voffB);
            PG8_BAR; PG8_WAIT_L(0); PG8_MMA(0, 1, At, B1); PG8_BAR;
            PG8_LDA(At, 0, 1); PG8_STAGE(PG8_SA(0, 0), a2, voffA);
            PG8_BAR; PG8_WAIT_L(0); PG8_MMA(1, 0, At, B0); PG8_BAR; PG8_SCHED;
            PG8_STAGE(PG8_SB(0, 1), b2 + hstep, voffB);
            PG8_WAIT_V(6); PG8_BAR; PG8_MMA(1, 1, At, B1); PG8_BAR;
            PG8_LDB(B0, 1, 0); PG8_SCHED; PG8_LDA(At, 1, 0); PG8_STAGE(PG8_SA(0, 1), a2 + hstep, voffA);
            PG8_WAIT_L(8); PG8_BAR; PG8_WAIT_L(0); PG8_MMA(0, 0, At, B0); PG8_BAR; PG8_SCHED;
            PG8_LDB(B1, 1, 1); PG8_STAGE(PG8_SB(1, 0), b3, voffB);
            PG8_BAR; PG8_WAIT_L(0); PG8_MMA(0, 1, At, B1); PG8_BAR;
            PG8_LDA(At, 1, 1); PG8_STAGE(PG8_SA(1, 0), a3, voffA);
            PG8_BAR; PG8_WAIT_L(0); PG8_MMA(1, 0, At, B0); PG8_BAR; PG8_SCHED;
            PG8_STAGE(PG8_SB(1, 1), b3 + hstep, voffB);
            PG8_WAIT_V(6); PG8_BAR; PG8_MMA(1, 1, At, B1); PG8_BAR;
        }
        PG8_STAMP();
        if constexpr (!Epi::AFTER_DRAIN) { E(acc, cur, wr, wc, fr, fq); S.done(cur); }
        PG8_STAMP();
        if (!has_next) break;
#pragma unroll
        for (int a = 0; a < 2; ++a)
#pragma unroll
            for (int b = 0; b < 2; ++b)
#pragma unroll
                for (int m = 0; m < 4; ++m)
#pragma unroll
                    for (int n = 0; n < 2; ++n) acc[a][b][m][n] = (f32x4){0.f, 0.f, 0.f, 0.f};
        cur = nxt; cA = nA; cB = nB; ++ui;
    }
    PG8_WAIT_V(0);
    if (wr == 0) PG8_BAR;
    PG8_BAR;
    if constexpr (Epi::AFTER_DRAIN) { E.fused(acc, cur, wr, wc, fr, fq, lds, wid, lane); S.done(cur); }
    PG8_STAMP();
    if (STAMP && wid == 0) { stamps[lane] = lane < nts ? (((unsigned long long)(unsigned)ts_hi << 32) | (unsigned)ts_lo) : 0ull;
        if (lane == 62) stamps[62] = rt_entry; if (lane == 63) stamps[63] = (unsigned long long)wall_clock64(); }
#undef PG8_STAMP
#undef PG8_SA
#undef PG8_SB
#undef PG8_STAGE
#undef PG8_LDA
#undef PG8_LDB
#undef PG8_MMA
#undef PG8_WAIT_V
#undef PG8_WAIT_L
#undef PG8_BAR
#undef PG8_SCHED
}
}
#define XB_TMO      128
#define XB_XCNT(j)  (256  + 64 * (j))
#define XB_XSUB(j)  (1280 + 64 * (j))
#define XB_XGEN(j)  (2304 + 64 * (j))
#define XB_TOP      3328
#define XB_TOPGEN   3392
#define XCD_BAR_WORDS 3456
#define XB_SPIN_CAP (1u << 18)
#define XLAS __attribute__((address_space(3)))
__device__ __forceinline__ unsigned xb_ld(unsigned* p)              { return __hip_atomic_load(p, __ATOMIC_RELAXED, __HIP_MEMORY_SCOPE_AGENT); }
__device__ __forceinline__ unsigned xb_add(unsigned* p, unsigned v) { return __hip_atomic_fetch_add(p, v, __ATOMIC_RELAXED, __HIP_MEMORY_SCOPE_AGENT); }
__device__ __forceinline__ unsigned xb_xcc_id() { return (unsigned)__builtin_amdgcn_s_getreg((3 << 11) | 20) & 0xFu; }
#define XB_SPIN(cond, bar) do { unsigned _sp = 0; while (cond) { __builtin_amdgcn_s_sleep(1); \
    if ((++_sp & 255u) == 0u) { if (xb_ld(&(bar)[XB_TMO])) break; if (_sp > XB_SPIN_CAP) { atomicAdd(&(bar)[XB_TMO], 1u); break; } } } } while (0)

struct XcdBarrier {
    unsigned* bar; unsigned x;
    volatile XLAS unsigned* st;
};

__device__ __forceinline__ XcdBarrier xcd_barrier_post(unsigned* bar, volatile XLAS unsigned* st) {
    XcdBarrier b; b.bar = bar; b.x = xb_xcc_id(); b.st = st;
    if (threadIdx.x == 0) (void)xb_add(&bar[XB_XCNT(b.x)], 1u);
    return b;
}
__device__ __forceinline__ void xcd_barrier_complete(unsigned* bar, unsigned x, unsigned& nloc, unsigned& nx) {
    const unsigned G = gridDim.x * gridDim.y * gridDim.z;
    unsigned sum, cnt, mine, sp = 0u;
    for (;;) {
        sum = 0u; cnt = 0u; mine = 0u;
#pragma unroll
        for (unsigned j = 0; j < 16; ++j) { const unsigned c = xb_ld(&bar[XB_XCNT(j)]); sum += c; cnt += (c > 0u) ? 1u : 0u; mine = (j == x) ? c : mine; }
        if (sum == G) break;
        __builtin_amdgcn_s_sleep(1);
        if ((++sp & 255u) == 0u) { if (xb_ld(&bar[XB_TMO])) break; if (sp > XB_SPIN_CAP) { atomicAdd(&bar[XB_TMO], 1u); break; } }
    }
    nloc = mine > 0u ? mine : 1u; nx = cnt > 0u ? cnt : 1u;
}

__device__ __forceinline__ void xcd_barrier(const XcdBarrier& b) {
    asm volatile("s_waitcnt vmcnt(0)" ::: "memory");
    __syncthreads();
    if (threadIdx.x == 0) {
        unsigned* bar = b.bar;
        __builtin_amdgcn_s_waitcnt(0);
        unsigned nloc = b.st[0], nx = b.st[1];
        if (nloc == 0u) { xcd_barrier_complete(bar, b.x, nloc, nx); b.st[0] = nloc; b.st[1] = nx; }
        const unsigned old = xb_add(&bar[XB_XSUB(b.x)], 1u);
        const unsigned gen = old / nloc;
        if (old + 1u == (gen + 1u) * nloc) {
            __builtin_amdgcn_fence(__ATOMIC_RELEASE, "agent");
            asm volatile("s_waitcnt vmcnt(0)" ::: "memory");
            const unsigned og = xb_add(&bar[XB_TOP], 1u);
            const unsigned tg = og / nx;
            if (og + 1u == (tg + 1u) * nx) xb_add(&bar[XB_TOPGEN], 1u);
            else XB_SPIN(xb_ld(&bar[XB_TOPGEN]) == tg, bar);
            __builtin_amdgcn_fence(__ATOMIC_ACQUIRE, "agent");
            xb_add(&bar[XB_XGEN(b.x)], 1u);
            asm volatile("s_waitcnt vmcnt(0)" ::: "memory");
        } else {
            XB_SPIN(xb_ld(&bar[XB_XGEN(b.x)]) == gen, bar);
            __builtin_amdgcn_fence(__ATOMIC_ACQUIRE, "agent");
            asm volatile("s_waitcnt vmcnt(0)" ::: "memory");
        }
    }
    __syncthreads();
}


using pg8::f32x4; using pg8::bf16x8; using pg8::u32x4; using pg8::Unit;
typedef unsigned short u16;
typedef unsigned u32x2 __attribute__((ext_vector_type(2)));
typedef float f32x2v __attribute__((ext_vector_type(2)));
typedef __bf16 bfv2 __attribute__((ext_vector_type(2)));
#define LAS PG8_LAS
#define DI __device__ __forceinline__

constexpr int M = 32768, D = 1024, FF = 2816, S0 = 16384, S1 = 2048;
constexpr int RS_OFF = 131072, RS_UNITS = 12, LDS_BYTES = 163840, XBW_OFF = LDS_BYTES - 256, PTR_OFF = XBW_OFF + 16;
constexpr int NPHASE = 22;

constexpr size_t W_FI0 = 0, W_FO0 = 11534336, W_FI1 = 17301504, W_FO1 = 28835840, W_X = 34603008;
constexpr size_t W_LRUIN = W_X, W_GATE = W_X + 4194304, W_LRUOUT = W_X + 5242880;
constexpr size_t W_QKV = W_X, W_WO = W_X + 18874368;
constexpr size_t WS_XB = 55574528, WS_SSQ = WS_XB + 67108864, WS_ROPE = WS_SSQ + 2097152, WS_BIG = WS_ROPE + 8388608;
constexpr size_t WS_HID = WS_BIG;
constexpr size_t WS_YB = WS_BIG, WS_UB = WS_BIG + 67108864, WS_PYB = WS_BIG + 134217728, WS_PYF = WS_XB;
constexpr size_t WS_SUMA = WS_BIG + 201326592, WS_SUMB = WS_SUMA + 2097152, WS_CF = WS_SUMB + 2097152, WS_CB = WS_CF + 1048576;
constexpr size_t WS_Q = WS_BIG, WS_K = WS_BIG + 100663296, WS_AO0 = WS_BIG + 201326592, OUT_VT = 0, OUT_AO1 = 100663296;
constexpr size_t WS_NRM = 0, WS_LSE = 6291456, WS_BAR = WS_BIG + 234881024, WS_END = WS_BAR + XCD_BAR_WORDS * 4;
static_assert(WS_END <= 369098752, "workspace map exceeds the guaranteed minimum");

struct Params { const float* in[18]; float* out; unsigned char* ws; };
struct PP { LAS const unsigned char* tab; unsigned char* ws;
    __device__ __forceinline__ const float* in(int i) const { const unsigned long long v = *(LAS const unsigned long long*)(tab + 8 * i);
        return (const float*)(__attribute__((address_space(1))) const float*)(((unsigned long long)(unsigned)__builtin_amdgcn_readfirstlane((int)(unsigned)(v >> 32)) << 32) | (unsigned long long)(unsigned)__builtin_amdgcn_readfirstlane((int)(unsigned)v)); }
    __device__ __forceinline__ float* out() const { return (float*)in(18); } };

DI int opaque_tid() { int t = threadIdx.x; asm volatile("" : "+v"(t)); return t; }
#define PIN(x) asm volatile("" : "+v"(x))
DI float bf2f(unsigned b) { return __uint_as_float(b << 16); }
DI unsigned pk2(float a, float b) { bfv2 r = __builtin_convertvector((f32x2v){a, b}, bfv2); return __builtin_bit_cast(unsigned, r); }
DI float sigm(float x) { return __builtin_amdgcn_rcpf(1.0f + __expf(-x)); }
DI float row_rstd(const float* ssq, int row) {
    const f32x4* p = (const f32x4*)(ssq + (size_t)row * 16);
    const f32x4 s = (p[0] + p[1]) + (p[2] + p[3]);
    return __builtin_amdgcn_rsqf(((s[0] + s[1]) + (s[2] + s[3])) * (1.0f / 1024.0f) + 1e-6f);
}

template <class Sched> DI void fill_rstd(LAS unsigned char* lds, const float* ssq, const Sched& S, int tid) {
    LAS float* tab = (LAS float*)(lds + RS_OFF);
#pragma unroll 1
    for (int k0 = 0; k0 < RS_UNITS; k0 += 4) {
        float v[2]; int ok[2];
#pragma unroll
        for (int q = 0; q < 2; ++q) { const int k = k0 + 2 * q + (tid >> 8); Unit u; ok[q] = S.next(k, u) ? 1 : 0; v[q] = ok[q] ? row_rstd(ssq, u.pm * 256 + (tid & 255)) : 0.f; }
#pragma unroll
        for (int q = 0; q < 2; ++q) { const int k = k0 + 2 * q + (tid >> 8); if (ok[q]) tab[k * 256 + (tid & 255)] = v[q]; }
    }
    __syncthreads();
}
DI void wave_rstd(LAS const unsigned char* lds, int k, int wr, int fr, float (&rs)[2][4]) {
    LAS const float* tab = (LAS const float*)(lds + RS_OFF) + k * 256 + wr * 64 + fr;
#pragma unroll
    for (int ai = 0; ai < 2; ++ai)
#pragma unroll
        for (int m = 0; m < 4; ++m) rs[ai][m] = tab[ai * 128 + m * 16];
}
struct EpiFFN1 {
    static constexpr bool PERM = true, AFTER_DRAIN = false;
    u16* hid; LAS const unsigned char* lds; mutable int cnt;
    DI void operator()(const f32x4 (&acc)[2][2][4][2], const Unit& u, int wr, int wc, int fr, int fq) const {
        const int row0 = u.pm * 256 + wr * 64 + fr, col0 = u.pn * 128 + wc * 32 + fq * 8;
        float rsv[2][4]; wave_rstd(lds, cnt, wr, fr, rsv); ++cnt;
#pragma unroll
        for (int ai = 0; ai < 2; ++ai)
#pragma unroll
            for (int m = 0; m < 4; ++m) {
                const int row = row0 + ai * 128 + m * 16; const float rs = rsv[ai][m], nrl = -1.4426950408889634f * rs, rs2 = rs * rs;
                u32x4 w;
#pragma unroll
                for (int n = 0; n < 2; ++n) {
                    const f32x4 g = acc[ai][0][m][n], up = acc[ai][1][m][n];
                    const f32x4 t = g * nrl, gu = (g * up) * rs2;
                    f32x4 ex;
#pragma unroll
                    for (int e = 0; e < 4; ++e) ex[e] = __builtin_amdgcn_exp2f(t[e]);
                    const f32x4 den = ex + 1.0f; f32x4 rc;
#pragma unroll
                    for (int e = 0; e < 4; ++e) rc[e] = __builtin_amdgcn_rcpf(den[e]);
                    const f32x4 h = gu * rc;
                    w[2 * n] = pk2(h[0], h[1]); w[2 * n + 1] = pk2(h[2], h[3]);
                }
#ifdef NT_STORE
                __builtin_nontemporal_store(w, (u32x4*)(hid + (size_t)row * FF + col0));
#else
                *(u32x4*)(hid + (size_t)row * FF + col0) = w;
#endif
            }
    }
};
struct EpiResid {
    static constexpr bool PERM = true, AFTER_DRAIN = false;
    const float* base0; const float* base1; float* out; u16* xb; float* ssq; const float* bias; float scale; int first, last, dry;
    DI void row_out(const f32x4 (&a)[2][2], const f32x4 (&bs)[2][2], int col0, int row, size_t off, int slot, int fq) const {
        float ss = 0.f;
#pragma unroll
        for (int bj = 0; bj < 2; ++bj) {
            const int c = bj * 128;
            f32x4 v0 = bs[bj][0] + a[bj][0] * scale, v1 = bs[bj][1] + a[bj][1] * scale;
            if (bias) { v0 += *(const f32x4*)(bias + col0 + c); v1 += *(const f32x4*)(bias + col0 + c + 4); }
            if (!dry) {
                if (last) { *(f32x4*)(out + off + c) = v0; *(f32x4*)(out + off + c + 4) = v1; }
                else { u32x4 w; w[0] = pk2(v0[0], v0[1]); w[1] = pk2(v0[2], v0[3]); w[2] = pk2(v1[0], v1[1]); w[3] = pk2(v1[2], v1[3]); *(u32x4*)(xb + off + c) = w; }
            }
            ss += (v0[0] * v0[0] + v0[1] * v0[1]) + (v0[2] * v0[2] + v0[3] * v0[3]) + (v1[0] * v1[0] + v1[1] * v1[1]) + (v1[2] * v1[2] + v1[3] * v1[3]);
        }
        ss += __shfl_xor(ss, 16); ss += __shfl_xor(ss, 32);
        if (fq == 0 && !dry) ssq[(size_t)row * 16 + slot] = ss;
    }
    DI void operator()(const f32x4 (&acc)[2][2][4][2], const Unit& u, int wr, int wc, int fr, int fq) const {
        const int row0 = u.pm * 256 + wr * 64 + fr, col0 = u.pn * 256 + wc * 32 + fq * 8, slot = u.pn * 4 + wc;
        if (first) {
#pragma unroll
          for (int ai = 0; ai < 2; ++ai) {
#pragma unroll
                for (int mp = 0; mp < 2; ++mp) {
                    f32x4 bsv[2][2][2];
#pragma unroll
                    for (int mm = 0; mm < 2; ++mm) { const int row = row0 + ai * 128 + (2 * mp + mm) * 16;
                        const float* bp = (row < S0 ? base0 + (size_t)row * D : base1 + (size_t)(row - S0) * D) + col0;
#pragma unroll
                        for (int bj = 0; bj < 2; ++bj) { bsv[mm][bj][0] = *(const f32x4*)(bp + bj * 128); bsv[mm][bj][1] = *(const f32x4*)(bp + bj * 128 + 4); } }
#pragma unroll
                    for (int mm = 0; mm < 2; ++mm) { const int m = 2 * mp + mm; const int row = row0 + ai * 128 + m * 16; const size_t off = (size_t)row * D + col0;
                        f32x4 a[2][2];
#pragma unroll
                        for (int bj = 0; bj < 2; ++bj) { a[bj][0] = acc[ai][bj][m][0]; a[bj][1] = acc[ai][bj][m][1]; }
                        row_out(a, bsv[mm], col0, row, off, slot, fq); }
                    asm volatile("" ::: "memory");
                }
          }
        } else {
            u32x4 raw[2][4][2];
#pragma unroll
            for (int ai = 0; ai < 2; ++ai)
#pragma unroll
                for (int m = 0; m < 4; ++m)
#pragma unroll
                    for (int bj = 0; bj < 2; ++bj) raw[ai][m][bj] = *(const u32x4*)(xb + (size_t)(row0 + ai * 128 + m * 16) * D + col0 + bj * 128);
#pragma unroll
            for (int ai = 0; ai < 2; ++ai)
#pragma unroll
                for (int m = 0; m < 4; ++m) {
                    const int row = row0 + ai * 128 + m * 16; const size_t off = (size_t)row * D + col0;
                    f32x4 bs[2][2], a[2][2];
#pragma unroll
                    for (int bj = 0; bj < 2; ++bj) { const u32x4 r = raw[ai][m][bj];
                        bs[bj][0] = (f32x4){bf2f(r[0] & 0xffffu), bf2f(r[0] >> 16), bf2f(r[1] & 0xffffu), bf2f(r[1] >> 16)};
                        bs[bj][1] = (f32x4){bf2f(r[2] & 0xffffu), bf2f(r[2] >> 16), bf2f(r[3] & 0xffffu), bf2f(r[3] >> 16)};
                        a[bj][0] = acc[ai][bj][m][0]; a[bj][1] = acc[ai][bj][m][1]; }
                    row_out(a, bs, col0, row, off, slot, fq);
                }
        }
    }
};
struct EpiLruIn {
    static constexpr bool PERM = true, AFTER_DRAIN = false;
    u16* yb; u16* ub; LAS const unsigned char* lds; const float* bias; mutable int cnt;
    DI void operator()(const f32x4 (&acc)[2][2][4][2], const Unit& u, int wr, int wc, int fr, int fq) const {
        const int row0 = u.pm * 256 + wr * 64 + fr, colg = u.pn * 256 + wc * 32 + fq * 8;
        const bool isy = u.pn < 4; u16* dst = isy ? yb : ub; const int cb = (u.pn & 3) * 256 + wc * 32 + fq * 8;
        float rsv[2][4]; wave_rstd(lds, cnt, wr, fr, rsv); ++cnt;
        f32x4 bv[2][2];
#pragma unroll
        for (int bj = 0; bj < 2; ++bj)
#pragma unroll
            for (int n = 0; n < 2; ++n) bv[bj][n] = *(const f32x4*)(bias + colg + bj * 128 + n * 4);
#pragma unroll
        for (int ai = 0; ai < 2; ++ai)
#pragma unroll
            for (int m = 0; m < 4; ++m) {
                const int row = row0 + ai * 128 + m * 16; const float rs = rsv[ai][m];
#pragma unroll
                for (int bj = 0; bj < 2; ++bj) {
                    u32x4 w;
#pragma unroll
                    for (int n = 0; n < 2; ++n) {
                        f32x4 v = acc[ai][bj][m][n] * rs + bv[bj][n];
                        if (isy) {
                            const f32x4 z = (v * v * 0.044715f + 1.0f) * v * (-1.5957691216f * 1.4426950408889634f); f32x4 ex;
#pragma unroll
                            for (int e = 0; e < 4; ++e) ex[e] = __builtin_amdgcn_exp2f(z[e]);
                            const f32x4 den = ex + 1.0f; f32x4 rc;
#pragma unroll
                            for (int e = 0; e < 4; ++e) rc[e] = __builtin_amdgcn_rcpf(den[e]);
                            v = v * rc;
                        }
                        w[2 * n] = pk2(v[0], v[1]); w[2 * n + 1] = pk2(v[2], v[3]);
                    }
                    *(u32x4*)(dst + (size_t)row * D + cb + bj * 128) = w;
                }
            }
    }
};
struct EpiQKV {
    static constexpr bool PERM = true, AFTER_DRAIN = false;
    u16* qb; u16* kb; u16* vt; float* nrm; LAS const unsigned char* lds; const float* qgain; const float* kgain; const float* rope; mutable int cnt;
    DI void operator()(const f32x4 (&acc)[2][2][4][2], const Unit& u, int wr, int wc, int fr, int fq) const {
        const int gt = u.pn >> 1, g = gt / 3, t = gt - 3 * g, hh = 2 * (u.pn & 1) + (wc >> 1), dlo = 32 * (wc & 1) + 8 * fq;
        const int row0 = u.pm * 256 + wr * 64 + fr;
        float rsv[2][4]; wave_rstd(lds, cnt, wr, fr, rsv); ++cnt;
        if (t < 2) {
            const float* gain = (t == 0 ? qgain : kgain) + g * 128;
            f32x4 glo[2], ghi[2], rc[2], rsn[2];
#pragma unroll
            for (int n = 0; n < 2; ++n) { glo[n] = *(const f32x4*)(gain + dlo + 4 * n); ghi[n] = *(const f32x4*)(gain + 64 + dlo + 4 * n);
                const f32x4 c0 = *(const f32x4*)(rope + ((size_t)16 * 64 + dlo + 4 * n) * 2), c1 = *(const f32x4*)(rope + ((size_t)16 * 64 + dlo + 4 * n) * 2 + 4);
                rc[n] = (f32x4){c0[0], c0[2], c1[0], c1[2]}; rsn[n] = (f32x4){c0[1], c0[3], c1[1], c1[3]}; }
            u16* dst = (t == 0 ? qb : kb) + (size_t)(g * 4 + hh) * M * 128;
            float* nr = nrm + (size_t)(g * 2 + t) * M * 8;
            f32x4 cs[2], sn[2];
            { const int pos = row0 < S0 ? row0 : ((row0 - S0) & (S1 - 1));
              const f32x4* rp = (const f32x4*)(rope + ((size_t)pos * 64 + dlo) * 2);
#pragma unroll
              for (int n = 0; n < 2; ++n) { const f32x4 c0 = rp[2 * n], c1 = rp[2 * n + 1]; cs[n] = (f32x4){c0[0], c0[2], c1[0], c1[2]}; sn[n] = (f32x4){c0[1], c0[3], c1[1], c1[3]}; } }
#pragma unroll
            for (int ai = 0; ai < 2; ++ai) {
                if (ai == 1) {
#pragma unroll
                    for (int st = 0; st < 5; ++st)
#pragma unroll
                        for (int n = 0; n < 2; ++n) { const f32x4 c2 = cs[n] * rc[n] - sn[n] * rsn[n], s2 = sn[n] * rc[n] + cs[n] * rsn[n]; cs[n] = c2; sn[n] = s2; }
                }
#pragma unroll
                for (int m = 0; m < 4; ++m) {
                    const int row = row0 + ai * 128 + m * 16; const float rs = rsv[ai][m];
                    float ss = 0.f; u32x4 wlo, whi;
#pragma unroll
                    for (int n = 0; n < 2; ++n) {
                        f32x4 lo = acc[ai][0][m][n] * rs, hi = acc[ai][1][m][n] * rs;
                        ss += (lo[0] * lo[0] + lo[1] * lo[1]) + (lo[2] * lo[2] + lo[3] * lo[3]) + (hi[0] * hi[0] + hi[1] * hi[1]) + (hi[2] * hi[2] + hi[3] * hi[3]);
                        lo *= glo[n]; hi *= ghi[n];
                        const f32x4 olo = lo * cs[n] - hi * sn[n], ohi = hi * cs[n] + lo * sn[n];
                        wlo[2 * n] = pk2(olo[0], olo[1]); wlo[2 * n + 1] = pk2(olo[2], olo[3]);
                        whi[2 * n] = pk2(ohi[0], ohi[1]); whi[2 * n + 1] = pk2(ohi[2], ohi[3]);
                        if (m < 3) { const f32x4 c2 = cs[n] * rc[n] - sn[n] * rsn[n], s2 = sn[n] * rc[n] + cs[n] * rsn[n]; cs[n] = c2; sn[n] = s2; }
                    }
                    *(u32x4*)(dst + (size_t)row * 128 + dlo) = wlo;
                    *(u32x4*)(dst + (size_t)row * 128 + 64 + dlo) = whi;
                    ss += __shfl_xor(ss, 16); ss += __shfl_xor(ss, 32);
                    if (fq == 0) nr[(size_t)row * 8 + hh * 2 + (wc & 1)] = ss;
                }
            }
        } else {
            u16* dst = vt + (size_t)(g * 4 + hh) * M * 128;
#pragma unroll
            for (int ai = 0; ai < 2; ++ai)
#pragma unroll
                for (int m = 0; m < 4; ++m) {
                    const int row = row0 + ai * 128 + m * 16; const float rs = rsv[ai][m];
#pragma unroll
                    for (int bj = 0; bj < 2; ++bj) {
                        const f32x4 v0 = acc[ai][bj][m][0] * rs, v1 = acc[ai][bj][m][1] * rs; u32x4 w;
                        w[0] = pk2(v0[0], v0[1]); w[1] = pk2(v0[2], v0[3]); w[2] = pk2(v1[0], v1[1]); w[3] = pk2(v1[2], v1[3]);
                        *(u32x4*)(dst + (size_t)row * 128 + 64 * bj + dlo) = w;
                    }
                }
        }
    }
};

DI int cvt_srccol(int mode, int n0) {
    if (mode == 1) { const int pn = n0 >> 8, c = n0 & 255; return c < 128 ? 128 * pn + c : FF + 128 * pn + (c - 128); }
    if (mode == 2) { const int p = n0 / 4608, rem = n0 - p * 4608, pn = rem >> 8, c = rem & 255, gt = pn >> 1, g = gt / 3, t = gt - 3 * g, hh = (c & 127) >> 6, db = 64 * (c >> 7); return g * 3072 + t * 1024 + (4 * p + 2 * (pn & 1) + hh) * 128 + db; }
    return n0;
}
template <int KT>
DI void cvt_job(LAS float* tile, const float* src, int ld, int K, int Nrows, int mode, const float* gk, u16* dst, int start, int stride) {
    const int tid = opaque_tid(), kt_n = K / KT, items = (Nrows >> 6) * kt_n;
    for (int it = start; it < items; it += stride) {
        const int nt = it / kt_n, kt = it - nt * kt_n, n0 = nt * 64, k0 = kt * KT, c0 = cvt_srccol(mode, n0);
        const int col = tid & 63, kr = tid >> 6;
        float v[KT / 8];
#pragma unroll
        for (int i = 0; i < KT / 8; ++i) v[i] = src[(size_t)(k0 + kr + 8 * i) * ld + c0 + col];
#pragma unroll
        for (int i = 0; i < KT / 8; ++i) { const int k = kr + 8 * i; float x = v[i]; if (gk) x *= gk[k0 + k]; tile[k * 65 + col] = x; }
        __syncthreads();
        const int r = tid >> 3;
#pragma unroll
        for (int j = 0; j < KT / 64; ++j) {
            const int kc = (tid & 7) * 8 + 64 * j; u32x4 w;
#pragma unroll
            for (int q = 0; q < 4; ++q) w[q] = pk2(tile[(kc + 2 * q) * 65 + r], tile[(kc + 2 * q + 1) * 65 + r]);
            *(u32x4*)(dst + (size_t)(n0 + r) * K + k0 + kc) = w;
        }
        __syncthreads();
    }
}
DI void convert_weights(LAS float* tile, const PP& p, int layer) {
    u16* W = (u16*)p.ws; const int G = gridDim.x, b = blockIdx.x;
    const float* ng = p.in(2) + (size_t)layer * 3 * D;
    for (int f = 0; f < 2; ++f) {
        cvt_job<256>(tile, p.in(3) + (size_t)(layer * 2 + f) * D * 2 * FF, 2 * FF, D, 2 * FF, 1, ng + (f == 0 ? 0 : 2 * D), (u16*)(p.ws + (f == 0 ? W_FI0 : W_FI1)), b, G);
        cvt_job<256>(tile, p.in(4) + (size_t)(layer * 2 + f) * FF * D, D, FF, D, 0, nullptr, (u16*)(p.ws + (f == 0 ? W_FO0 : W_FO1)), (b + 64) % G, G);
    }
    if (layer == 0) {
        cvt_job<256>(tile, p.in(5), 2 * D, D, 2 * D, 0, ng + D, (u16*)(p.ws + W_LRUIN), (b + 128) % G, G);
        for (int q = b; q < 32; q += G) cvt_job<64>(tile, p.in(9) + (size_t)q * 16384, 128, 128, 128, 0, nullptr, (u16*)(p.ws + W_GATE) + (size_t)q * 16384, 0, 1);
        cvt_job<256>(tile, p.in(12), D, D, D, 0, nullptr, (u16*)(p.ws + W_LRUOUT), (b + 192) % G, G);
    } else {
        cvt_job<256>(tile, p.in(14), 9216, D, 9216, 2, ng + D, (u16*)(p.ws + W_QKV), (b + 128) % G, G);
        cvt_job<256>(tile, p.in(17), D, D, D, 0, nullptr, (u16*)(p.ws + W_WO), (b + 192) % G, G);
    }
    (void)W;
}
DI void prologue_x(const PP& p) {
    const int tid = opaque_tid(), lane = tid & 63, wave = tid >> 6;
    u16* xb = (u16*)(p.ws + WS_XB); float* ssq = (float*)(p.ws + WS_SSQ);
    for (int row0 = blockIdx.x * 8 + wave; row0 < M; row0 += gridDim.x * 16) {
        f32x4 v[2][4]; int rows[2];
#pragma unroll
        for (int q = 0; q < 2; ++q) { const int row = row0 + q * gridDim.x * 8 < M ? row0 + q * gridDim.x * 8 : row0; rows[q] = row;
            const float* src = row < S0 ? p.in(0) + (size_t)row * D : p.in(1) + (size_t)(row - S0) * D;
#pragma unroll
            for (int i = 0; i < 4; ++i) v[q][i] = *(const f32x4*)(src + i * 256 + lane * 4); }
#pragma unroll
        for (int q = 0; q < 2; ++q) { const int row = rows[q]; float ss = 0.f;
#pragma unroll
            for (int i = 0; i < 4; ++i) { const f32x4 x = v[q][i]; ss += (x[0] * x[0] + x[1] * x[1]) + (x[2] * x[2] + x[3] * x[3]);
                u32x2 w; w.x = pk2(x[0], x[1]); w.y = pk2(x[2], x[3]); *(u32x2*)(xb + (size_t)row * D + i * 256 + lane * 4) = w; }
#pragma unroll
            for (int o = 32; o >= 1; o >>= 1) ss += __shfl_xor(ss, o);
            if (lane < 16) ssq[(size_t)row * 16 + lane] = lane == 0 ? ss : 0.f; }
    }
    f32x2v* tab = (f32x2v*)(p.ws + WS_ROPE);
    for (int idx = blockIdx.x * 512 + tid; idx < S0 * 64; idx += gridDim.x * 512) {
        const int pos = idx >> 6, i = idx & 63;
        const float e = -2.0f * (float)i / 128.0f; const float inv = (float)exp2((double)e * 13.287712379549449);
        const float ang = (float)pos * inv; const double a = (double)ang, nn = rint(a * 0.15915494309189535); const float rf = (float)(a - nn * 6.283185307179586);
        tab[idx] = (f32x2v){cosf(rf), sinf(rf)};
    }
}

constexpr int LT_STRIDE = 272, LT_ROWS = 128, HF_OFF = LT_ROWS * LT_STRIDE, HF_STRIDE = 132, NCHUNK = M / LT_ROWS;
template <int DIR>
DI void lru_dir(LAS unsigned char* lds, const bf16x8 (&Bf)[2][4], float gbr, float gbi, float c8, int wave, int fr, int fq, int row0, int ch,
                u16* yb, u16* pyo, float* sumA, float* sumB, int tt, int dry) {
    LAS const unsigned char* tile = lds; LAS float* hfl = (LAS float*)(lds + HF_OFF);
    const int j = wave * 16 + fr;
    float Arun = 1.f, Brun = 0.f;
    const int oq = DIR ? 3 - fq : fq; const int lane = fq * 16 + fr;
    const int p16 = DIR ? lane + 16 : lane - 16, p32 = DIR ? lane + 32 : lane - 32, ptot = DIR ? fr : fr + 48;
    unsigned short ycur[4];
    { const int mt0 = DIR ? LT_ROWS / 16 - 1 : 0;
#pragma unroll
      for (int r = 0; r < 4; ++r) ycur[r] = yb[(unsigned)(row0 + 16 * mt0 + 4 * fq + r) * D + ch]; }
#pragma unroll 1
    for (int it = 0; it < LT_ROWS / 16; ++it) {
        const int mt = DIR ? LT_ROWS / 16 - 1 - it : it;
        unsigned short ynext[4];
        { const int itn = it + 1 < LT_ROWS / 16 ? it + 1 : it; const int mtn = DIR ? LT_ROWS / 16 - 1 - itn : itn;
#pragma unroll
          for (int r = 0; r < 4; ++r) ynext[r] = yb[(unsigned)(row0 + 16 * mtn + 4 * fq + r) * D + ch]; }
        f32x4 dr = {0.f, 0.f, 0.f, 0.f}, di = {0.f, 0.f, 0.f, 0.f};
#pragma unroll
        for (int ks = 0; ks < 4; ++ks) {
            const bf16x8 a = *(LAS const bf16x8*)(tile + (16 * mt + fr) * LT_STRIDE + (32 * ks + 8 * fq) * 2);
            dr = __builtin_amdgcn_mfma_f32_16x16x32_bf16(a, Bf[0][ks], dr, 0, 0, 0);
            di = __builtin_amdgcn_mfma_f32_16x16x32_bf16(a, Bf[1][ks], di, 0, 0, 0);
        }
        float av[4], bv[4];
        {
            f32x4 uc4;
#pragma unroll
            for (int r = 0; r < 4; ++r) uc4[r] = bf2f(*(LAS const u16*)(tile + (16 * mt + 4 * fq + r) * LT_STRIDE + j * 2));
            const f32x4 tr = (dr + gbr) * -1.4426950408889634f, ti = (di + gbi) * -1.4426950408889634f;
            f32x4 er, ei;
#pragma unroll
            for (int r = 0; r < 4; ++r) { er[r] = __builtin_amdgcn_exp2f(tr[r]); ei[r] = __builtin_amdgcn_exp2f(ti[r]); }
            const f32x4 dr1 = er + 1.0f, di1 = ei + 1.0f;
            f32x4 rg, ig;
#pragma unroll
            for (int r = 0; r < 4; ++r) { rg[r] = __builtin_amdgcn_rcpf(dr1[r]); ig[r] = __builtin_amdgcn_rcpf(di1[r]); }
            const f32x4 la = rg * (-1.4426950408889634f * c8);
            f32x4 a4;
#pragma unroll
            for (int r = 0; r < 4; ++r) a4[r] = __builtin_amdgcn_exp2f(la[r]);
            const f32x4 om = 1.0f - a4 * a4, iu = ig * uc4;
            f32x4 sq4;
#pragma unroll
            for (int r = 0; r < 4; ++r) sq4[r] = __builtin_amdgcn_sqrtf(fmaxf(om[r], 0.f));
            const f32x4 b4 = sq4 * iu;
#pragma unroll
            for (int r = 0; r < 4; ++r) { av[r] = a4[r]; bv[r] = b4[r]; }
        }
        float Ap[4], Bp[4];
#pragma unroll
        for (int q = 0; q < 4; ++q) { const int r = DIR ? 3 - q : q; if (q == 0) { Ap[0] = av[r]; Bp[0] = bv[r]; } else { Ap[q] = av[r] * Ap[q - 1]; Bp[q] = av[r] * Bp[q - 1] + bv[r]; } }
        float Ai = Ap[3], Bi = Bp[3];
        { const float pa = __shfl(Ai, p16), pb = __shfl(Bi, p16); if (oq >= 1) { Bi = Ai * pb + Bi; Ai = Ai * pa; } }
        { const float pa = __shfl(Ai, p32), pb = __shfl(Bi, p32); if (oq >= 2) { Bi = Ai * pb + Bi; Ai = Ai * pa; } }
        float ea = __shfl(Ai, p16), eb = __shfl(Bi, p16); if (oq == 0) { ea = 1.f; eb = 0.f; }
        const float ta = __shfl(Ai, ptot), tb = __shfl(Bi, ptot);
        const float Ax = ea * Arun, Bx = ea * Brun + eb;
#pragma unroll
        for (int q = 0; q < 4; ++q) {
            const int r = DIR ? 3 - q : q; const float h = Ap[q] * Bx + Bp[q], P = Ap[q] * Ax;
            const int tok = 16 * mt + 4 * fq + r;
            const unsigned off = (unsigned)(row0 + tok) * D + ch;
            const float y = bf2f(ycur[r]);
            if (DIR == 0) { hfl[tok * HF_STRIDE + j] = h; if (!dry) pyo[off] = (u16)(pk2(P * y, 0.f) & 0xffffu); }
            else { const float hv = (hfl[tok * HF_STRIDE + j] + h) * y; if (!dry) { yb[off] = (u16)(pk2(hv, 0.f) & 0xffffu); pyo[off] = (u16)(pk2(P * y, 0.f) & 0xffffu); } }
        }
        Brun = ta * Brun + tb; Arun = ta * Arun;
#pragma unroll
        for (int r = 0; r < 4; ++r) ycur[r] = ynext[r];
    }
    if (fq == 0 && !dry) { sumA[(size_t)(DIR * NCHUNK + tt) * D + ch] = Arun; sumB[(size_t)(DIR * NCHUNK + tt) * D + ch] = Brun; }
}
DI void lru_l1(LAS unsigned char* lds, const PP& p, int dry) {
    const int tid = opaque_tid(), lane = tid & 63, wave = tid >> 6, fr = lane & 15, fq = lane >> 4;
    const u16* ub = (const u16*)(p.ws + WS_UB); u16* yb = (u16*)(p.ws + WS_YB); u16* pyf = (u16*)p.out();     u16* pyb = (u16*)(p.ws + WS_PYB);
    const u16* wg = (const u16*)(p.ws + W_GATE); float* sumA = (float*)(p.ws + WS_SUMA); float* sumB = (float*)(p.ws + WS_SUMB);
    const float* conv_w = p.in(7); const float* conv_b = p.in(8);
    for (int unit = blockIdx.x; unit < NCHUNK * 8; unit += gridDim.x) {
        const int tt = unit >> 3, n = unit & 7, row0 = tt * LT_ROWS;
        const int sbase = row0 < S0 ? 0 : S0 + ((row0 - S0) & ~(S1 - 1)), send = sbase + (row0 < S0 ? S0 : S1);
        bf16x8 BfA[2][2][4]; float gbv[2][2], lamv[2];
        { const int j = wave * 16 + fr;
#pragma unroll
          for (int dd = 0; dd < 2; ++dd) {
#pragma unroll
            for (int gg = 0; gg < 2; ++gg) {
#pragma unroll
                for (int ks = 0; ks < 4; ++ks) BfA[dd][gg][ks] = *(const bf16x8*)(wg + ((size_t)((dd * 2 + gg) * 8 + n) * 128 + j) * 128 + 32 * ks + 8 * fq);
                gbv[dd][gg] = p.in(10)[((dd * 2 + gg) * 8 + n) * 128 + j]; }
            lamv[dd] = p.in(11)[dd * D + n * 128 + j]; } }
        {
            const int c = tid & 15, ch8 = n * 128 + c * 8;
            float w[4][8], cb[8];
#pragma unroll
            for (int k = 0; k < 4; ++k) { const f32x4 a = *(const f32x4*)(conv_w + k * D + ch8), b = *(const f32x4*)(conv_w + k * D + ch8 + 4);
#pragma unroll
                for (int e = 0; e < 4; ++e) { w[k][e] = a[e]; w[k][4 + e] = b[e]; } }
            { const f32x4 a = *(const f32x4*)(conv_b + ch8), b = *(const f32x4*)(conv_b + ch8 + 4);
#pragma unroll
                for (int e = 0; e < 4; ++e) { cb[e] = a[e]; cb[4 + e] = b[e]; } }
            u32x4 tap[LT_ROWS / 32][4];
#pragma unroll
            for (int i = 0; i < LT_ROWS / 32; ++i)
#pragma unroll
                for (int k = 0; k < 4; ++k) { const int rr = row0 + (tid >> 4) + 32 * i + k - 2; const int rc = min(max(rr, sbase), send - 1); tap[i][k] = *(const u32x4*)(ub + (size_t)rc * D + ch8); }
#pragma unroll
            for (int i = 0; i < LT_ROWS / 32; ++i) {
                const int r = (tid >> 4) + 32 * i, row = row0 + r; float acc[8];
#pragma unroll
                for (int e = 0; e < 8; ++e) acc[e] = cb[e];
#pragma unroll
                for (int k = 0; k < 4; ++k) { const int rr = row + k - 2; const float in = (rr >= sbase && rr < send) ? 1.0f : 0.0f; const u32x4 v = tap[i][k];
#pragma unroll
                    for (int e = 0; e < 4; ++e) { acc[2 * e] += (w[k][2 * e] * in) * bf2f(v[e] & 0xffffu); acc[2 * e + 1] += (w[k][2 * e + 1] * in) * bf2f(v[e] >> 16); } }
                u32x4 o;
#pragma unroll
                for (int e = 0; e < 4; ++e) o[e] = pk2(acc[2 * e], acc[2 * e + 1]);
                *(LAS u32x4*)(lds + r * LT_STRIDE + c * 16) = o;
            }
        }
        __syncthreads();
        {
            const int ch = n * 128 + wave * 16 + fr;
            float c8v[2];
#pragma unroll
            for (int dd = 0; dd < 2; ++dd) { const float nl = -lamv[dd]; c8v[dd] = 8.0f * (fmaxf(nl, 0.f) + log1pf(expf(-fabsf(nl)))); }
            lru_dir<0>(lds, BfA[0], gbv[0][0], gbv[0][1], c8v[0], wave, fr, fq, row0, ch, yb, pyf, sumA, sumB, tt, dry);
            lru_dir<1>(lds, BfA[1], gbv[1][0], gbv[1][1], c8v[1], wave, fr, fq, row0, ch, yb, pyb, sumA, sumB, tt, dry);
        }
        __syncthreads();
    }
}
DI void lru_carry(const PP& p) {
    const float* sumA = (const float*)(p.ws + WS_SUMA); const float* sumB = (const float*)(p.ws + WS_SUMB);
    float* cF = (float*)(p.ws + WS_CF); float* cB = (float*)(p.ws + WS_CB);
    const int gt = blockIdx.x * 512 + opaque_tid();
    if (gt < 9 * 2 * D) {
        const int ch = gt & (D - 1), d = (gt >> 10) & 1, s = gt >> 11;
        const int t0 = s == 0 ? 0 : 128 + 16 * (s - 1), nt = s == 0 ? 128 : 16; float c = 0.f;
        if (d == 0) {
#pragma unroll 16
            for (int k = 0; k < nt; ++k) { const int tt = t0 + k; cF[(size_t)tt * D + ch] = c; c = sumA[(size_t)tt * D + ch] * c + sumB[(size_t)tt * D + ch]; }
        } else {
#pragma unroll 16
            for (int k = nt - 1; k >= 0; --k) { const int tt = t0 + k; cB[(size_t)tt * D + ch] = c; c = sumA[(size_t)(NCHUNK + tt) * D + ch] * c + sumB[(size_t)(NCHUNK + tt) * D + ch]; }
        }
    }
}
DI void lru_l3(const PP& p) {
    u16* yb = (u16*)(p.ws + WS_YB); const u16* pyf = (const u16*)p.out(); const u16* pyb = (const u16*)(p.ws + WS_PYB);
    const float* cF = (const float*)(p.ws + WS_CF); const float* cB = (const float*)(p.ws + WS_CB);
    const int nth = gridDim.x * 512;
    for (int idx0 = blockIdx.x * 512 + opaque_tid(); idx0 < M * 128; idx0 += 4 * nth) {
        u32x4 h[4], f[4], bb[4]; f32x4 f0[4], f1[4], b0[4], b1[4];
#pragma unroll
        for (int q = 0; q < 4; ++q) {
            int idx = idx0 + q * nth; if (idx >= M * 128) idx = idx0; const int row = idx >> 7, c8 = (idx & 127) * 8, tt = row >> 7; const size_t off = (size_t)row * D + c8;
            h[q] = *(const u32x4*)(yb + off); f[q] = *(const u32x4*)(pyf + off); bb[q] = *(const u32x4*)(pyb + off);
            f0[q] = *(const f32x4*)(cF + (size_t)tt * D + c8); f1[q] = *(const f32x4*)(cF + (size_t)tt * D + c8 + 4);
            b0[q] = *(const f32x4*)(cB + (size_t)tt * D + c8); b1[q] = *(const f32x4*)(cB + (size_t)tt * D + c8 + 4);
        }
#pragma unroll
        for (int q = 0; q < 4; ++q) {
            const int idx = idx0 + q * nth; if (idx >= M * 128) continue; const int row = idx >> 7, c8 = (idx & 127) * 8; const size_t off = (size_t)row * D + c8;
            u32x4 o;
#pragma unroll
            for (int e = 0; e < 4; ++e) {
                const float cf0 = e < 2 ? f0[q][2 * e] : f1[q][2 * e - 4], cf1 = e < 2 ? f0[q][2 * e + 1] : f1[q][2 * e - 3];
                const float cb0 = e < 2 ? b0[q][2 * e] : b1[q][2 * e - 4], cb1 = e < 2 ? b0[q][2 * e + 1] : b1[q][2 * e - 3];
                const float v0 = bf2f(h[q][e] & 0xffffu) + bf2f(f[q][e] & 0xffffu) * cf0 + bf2f(bb[q][e] & 0xffffu) * cb0;
                const float v1 = bf2f(h[q][e] >> 16) + bf2f(f[q][e] >> 16) * cf1 + bf2f(bb[q][e] >> 16) * cb1;
                o[e] = pk2(v0, v1);
            }
            *(u32x4*)(yb + off) = o;
        }
    }
}

constexpr int AK_STRIDE = 272, AK_ROWS = 272, AV_OFF = AK_ROWS * AK_STRIDE, AV_STRIDE = 288, ARK_OFF = AV_OFF + AK_ROWS * AV_STRIDE, NSU = 12 * (M / 128);
static_assert(ARK_OFF + AK_ROWS * 4 <= XBW_OFF, "attention LDS image must stay below the barrier words");
template <int TP, int DH> DI void tr8(unsigned base, u32x2 (&v)[8]) {
    asm volatile(
        "ds_read_b64_tr_b16 %0, %8 offset:%9\n\tds_read_b64_tr_b16 %1, %8 offset:%10\n\tds_read_b64_tr_b16 %2, %8 offset:%11\n\tds_read_b64_tr_b16 %3, %8 offset:%12\n\t"
        "ds_read_b64_tr_b16 %4, %8 offset:%13\n\tds_read_b64_tr_b16 %5, %8 offset:%14\n\tds_read_b64_tr_b16 %6, %8 offset:%15\n\tds_read_b64_tr_b16 %7, %8 offset:%16\n\ts_waitcnt lgkmcnt(0)"
        : "=&v"(v[0]), "=&v"(v[1]), "=&v"(v[2]), "=&v"(v[3]), "=&v"(v[4]), "=&v"(v[5]), "=&v"(v[6]), "=&v"(v[7])
        : "v"(base), "i"((TP * 32) * AV_STRIDE + (4 * DH + 0) * 32), "i"((TP * 32 + 16) * AV_STRIDE + (4 * DH + 0) * 32), "i"((TP * 32) * AV_STRIDE + (4 * DH + 1) * 32), "i"((TP * 32 + 16) * AV_STRIDE + (4 * DH + 1) * 32),
          "i"((TP * 32) * AV_STRIDE + (4 * DH + 2) * 32), "i"((TP * 32 + 16) * AV_STRIDE + (4 * DH + 2) * 32), "i"((TP * 32) * AV_STRIDE + (4 * DH + 3) * 32), "i"((TP * 32 + 16) * AV_STRIDE + (4 * DH + 3) * 32)
        : "memory");
}
template <int TP> DI void pv_pair(unsigned vbase, const bf16x8 Pf, f32x4 (&O)[8]) {
    { u32x2 v[8]; tr8<TP, 0>(vbase, v);
#pragma unroll
      for (int i = 0; i < 4; ++i) { const u32x4 vw = {v[2 * i].x, v[2 * i].y, v[2 * i + 1].x, v[2 * i + 1].y}; O[i] = __builtin_amdgcn_mfma_f32_16x16x32_bf16(__builtin_bit_cast(bf16x8, vw), Pf, O[i], 0, 0, 0); } }
    { u32x2 v[8]; tr8<TP, 1>(vbase, v);
#pragma unroll
      for (int i = 0; i < 4; ++i) { const u32x4 vw = {v[2 * i].x, v[2 * i].y, v[2 * i + 1].x, v[2 * i + 1].y}; O[4 + i] = __builtin_amdgcn_mfma_f32_16x16x32_bf16(__builtin_bit_cast(bf16x8, vw), Pf, O[4 + i], 0, 0, 0); } }
}
struct AttnGeo { int gh, g, dsh, sbase, L, rho, Q0; };
DI AttnGeo attn_geo(int su) {
    AttnGeo a; a.gh = su >> 8; const int w = su & 255; a.g = a.gh >> 2; a.dsh = 2 * a.g;
    const int lin = (w & 7) * 32 + (w >> 3);
    int nblk, lis; if (lin < 128) { a.sbase = 0; nblk = 128; lis = lin; } else { a.sbase = S0 + ((lin - 128) >> 4) * S1; nblk = 16; lis = (lin - 128) & 15; }
    const int S = lin < 128 ? S0 : S1; a.L = S >> a.dsh;
    const int C = nblk < 32 ? nblk : 32, c = lis / C, within = lis - c * C, d = 1 << a.dsh;
    a.rho = within & (d - 1); a.Q0 = (c * (C >> a.dsh) + (within >> a.dsh)) * 128; return a;
}
struct AttnRegs { u32x4 k[9]; u32x4 v[9]; f32x2v nk; bf16x8 q[4]; f32x2v nq; };
template <bool DOK, bool DOV> DI void attn_issue(const AttnGeo& a, int tid, int wave, int fr, int fq, const u16* qbuf, const u16* kbuf, const u16* vtb, const float* nrm, AttnRegs& R) {
    const u16* Q = qbuf + (size_t)a.gh * M * 128; const u16* K = kbuf + (size_t)a.gh * M * 128; const u16* V = vtb + (size_t)a.gh * M * 128;
    const int hh = a.gh & 3;
    const float* nqp = nrm + (size_t)(a.g * 2 + 0) * M * 8 + hh * 2; const float* nkp = nrm + (size_t)(a.g * 2 + 1) * M * 8 + hh * 2;
#pragma unroll
    for (int i = 0; i < 9; ++i) { const int pc = tid + 512 * i; const int j = min(pc >> 4, AK_ROWS - 1), c = pc & 15;
        const int kc = min(max(a.Q0 - 64 + j, 0), a.L - 1); const size_t ro = (size_t)(a.sbase + (kc << a.dsh) + a.rho) * 128 + 8 * c;
        if (DOK) R.k[i] = *(const u32x4*)(K + ro); if (DOV) R.v[i] = *(const u32x4*)(V + ro); }
    if (!DOK) return;
    { const int j = min(tid, AK_ROWS - 1); const int kc = min(max(a.Q0 - 64 + j, 0), a.L - 1); R.nk = *(const f32x2v*)(nkp + (size_t)(a.sbase + (kc << a.dsh) + a.rho) * 8); }
    { const size_t qrow = (size_t)(a.sbase + ((a.Q0 + 16 * wave + fr) << a.dsh) + a.rho);
#pragma unroll
      for (int ks = 0; ks < 4; ++ks) R.q[ks] = *(const bf16x8*)(Q + qrow * 128 + 32 * ks + 8 * fq);
      R.nq = *(const f32x2v*)(nqp + qrow * 8); }
}
DI void attn_phase(LAS unsigned char* lds, const PP& p, int dry) {
    const int tid = opaque_tid(), lane = tid & 63, wave = tid >> 6, fr = lane & 15, fq = lane >> 4;
    u16* qbuf = (u16*)(p.ws + WS_Q); const u16* kbuf = (const u16*)(p.ws + WS_K); const u16* vtb = (const u16*)((const unsigned char*)p.out() + OUT_VT);
    const float* nrm = (const float*)(p.ws + WS_NRM); float* lse = (float*)(p.ws + WS_LSE);
    const int G = gridDim.x;
    int su = blockIdx.x;
    AttnRegs R;
    if (su < NSU) { const AttnGeo a0 = attn_geo(su); attn_issue<true, true>(a0, tid, wave, fr, fq, qbuf, kbuf, vtb, nrm, R); }
    while (su < NSU) {
        const AttnGeo a = attn_geo(su);
#pragma unroll
        for (int i = 0; i < 9; ++i) { const int pc = tid + 512 * i; if (pc < AK_ROWS * 16) *(LAS u32x4*)(lds + (pc >> 4) * AK_STRIDE + (pc & 15) * 16) = R.k[i]; }
#pragma unroll
        for (int i = 0; i < 9; ++i) { const int pc = tid + 512 * i; if (pc < AK_ROWS * 16) *(LAS u32x4*)(lds + AV_OFF + (pc >> 4) * AV_STRIDE + (pc & 15) * 16) = R.v[i]; }
        if (tid < AK_ROWS) *(LAS float*)(lds + ARK_OFF + tid * 4) = __builtin_amdgcn_rsqf((R.nk.x + R.nk.y) * (1.0f / 128.0f) + 1e-6f);
        bf16x8 Qf[4];
#pragma unroll
        for (int ks = 0; ks < 4; ++ks) Qf[ks] = R.q[ks];
        const float sq = __builtin_amdgcn_rsqf((R.nq.x + R.nq.y) * (1.0f / 128.0f) + 1e-6f) * 0.08838834764831845f;
        __syncthreads();
        const int nxt = su + G;
        int tidl = tid; asm volatile("" : "+v"(tidl));
        if (nxt < NSU) { const AttnGeo an = attn_geo(nxt); attn_issue<true, false>(an, tidl, tidl >> 6, tidl & 15, (tidl >> 4) & 3, qbuf, kbuf, vtb, nrm, R); }
        f32x4 Sc[9];
        const int jw = 16 * wave;
#pragma unroll
        for (int T = 0; T < 9; ++T) {
            f32x4 acc = {0.f, 0.f, 0.f, 0.f};
#pragma unroll
            for (int ks = 0; ks < 4; ++ks) { const bf16x8 kf = *(LAS const bf16x8*)(lds + (jw + 16 * T + fr) * AK_STRIDE + (32 * ks + 8 * fq) * 2);
                acc = __builtin_amdgcn_mfma_f32_16x16x32_bf16(kf, Qf[ks], acc, 0, 0, 0); }
            const f32x4 rk = *(LAS const f32x4*)(lds + ARK_OFF + (jw + 16 * T + 4 * fq) * 4);
#pragma unroll
            for (int r = 0; r < 4; ++r) {
                const int dd = 16 * T + 4 * fq + r - 64 - fr, kk = a.Q0 + jw + fr + dd;
                const bool ok = dd <= 64 && dd >= -64 && kk >= 0 && kk < a.L;
                Sc[T][r] = ok ? acc[r] * sq * rk[r] : -1e30f;
            }
        }
        float mx = -1e30f;
#pragma unroll
        for (int T = 0; T < 9; ++T)
#pragma unroll
            for (int r = 0; r < 4; ++r) mx = fmaxf(mx, Sc[T][r]);
        mx = fmaxf(mx, __shfl_xor(mx, 16)); mx = fmaxf(mx, __shfl_xor(mx, 32));
        float sum = 0.f;
#pragma unroll
        for (int T = 0; T < 9; ++T)
#pragma unroll
            for (int r = 0; r < 4; ++r) { const float ev = __expf(Sc[T][r] - mx); Sc[T][r] = ev; sum += ev; }
        sum += __shfl_xor(sum, 16); sum += __shfl_xor(sum, 32);
        const float linv = 1.0f / sum, lsev = mx + __logf(sum);
        if (nxt < NSU) { const AttnGeo an = attn_geo(nxt); attn_issue<false, true>(an, tidl, tidl >> 6, tidl & 15, (tidl >> 4) & 3, qbuf, kbuf, vtb, nrm, R); }
        f32x4 O[8];
#pragma unroll
        for (int dt = 0; dt < 8; ++dt) O[dt] = (f32x4){0.f, 0.f, 0.f, 0.f};
        {
            const unsigned vbase = (unsigned)(size_t)lds + AV_OFF + (jw + 4 * fq + (fr >> 2)) * AV_STRIDE + 8 * (fr & 3);
#define PFRAG(tp_, hi_) ({ u32x4 w_; w_[0] = pk2(Sc[2 * (tp_)][0], Sc[2 * (tp_)][1]); w_[1] = pk2(Sc[2 * (tp_)][2], Sc[2 * (tp_)][3]); \
            if (hi_) { w_[2] = pk2(Sc[(hi_) ? 2 * (tp_) + 1 : 0][0], Sc[(hi_) ? 2 * (tp_) + 1 : 0][1]); w_[3] = pk2(Sc[(hi_) ? 2 * (tp_) + 1 : 0][2], Sc[(hi_) ? 2 * (tp_) + 1 : 0][3]); } else { w_[2] = 0u; w_[3] = 0u; } \
            __builtin_bit_cast(bf16x8, w_); })
            pv_pair<0>(vbase, PFRAG(0, 1), O); pv_pair<1>(vbase, PFRAG(1, 1), O); pv_pair<2>(vbase, PFRAG(2, 1), O); pv_pair<3>(vbase, PFRAG(3, 1), O);
            pv_pair<4>(vbase, PFRAG(4, 0), O);
#undef PFRAG
        }
        if (!dry) {
            u16* Q = qbuf + (size_t)a.gh * M * 128; const size_t qrow = (size_t)(a.sbase + ((a.Q0 + jw + fr) << a.dsh) + a.rho);
#pragma unroll
            for (int dt = 0; dt < 8; ++dt) { const f32x4 o = O[dt] * linv; u32x2 w; w.x = pk2(o[0], o[1]); w.y = pk2(o[2], o[3]); *(u32x2*)(Q + qrow * 128 + 16 * dt + 4 * fq) = w; }
            if (fq == 0) lse[(size_t)a.gh * M + qrow] = lsev;
        }
        __syncthreads();
        su = nxt;
    }
}
DI void attn_merge(const PP& p, int pass) {
    const u16* qbuf = (const u16*)(p.ws + WS_Q); const float* lse = (const float*)(p.ws + WS_LSE);
    u16* ao0 = (u16*)(p.ws + WS_AO0); u16* ao1 = (u16*)((unsigned char*)p.out() + OUT_AO1);
    const int nth = gridDim.x * 512;
    for (int idx0 = blockIdx.x * 512 + opaque_tid(); idx0 < M * 64; idx0 += 2 * nth) {
        float l[2][3]; u32x4 a[2][3];
#pragma unroll
        for (int q = 0; q < 2; ++q) { int idx = idx0 + q * nth; if (idx >= M * 64) idx = idx0; const int c = idx & 15, hh = (idx >> 4) & 3, row = idx >> 6;
#pragma unroll
            for (int g = 0; g < 3; ++g) { l[q][g] = lse[(size_t)(4 * g + hh) * M + row]; a[q][g] = *(const u32x4*)(qbuf + ((size_t)(4 * g + hh) * M + row) * 128 + 8 * c); } }
#pragma unroll
        for (int q = 0; q < 2; ++q) { const int idx = idx0 + q * nth; if (idx >= M * 64) continue; const int c = idx & 15, hh = (idx >> 4) & 3, row = idx >> 6;
            const float mx = fmaxf(l[q][0], fmaxf(l[q][1], l[q][2])); float w0 = __expf(l[q][0] - mx), w1 = __expf(l[q][1] - mx), w2 = __expf(l[q][2] - mx);
            const float inv = 1.0f / (w0 + w1 + w2); w0 *= inv; w1 *= inv; w2 *= inv;
            u32x4 o;
#pragma unroll
            for (int e = 0; e < 4; ++e) {
                const float v0 = w0 * bf2f(a[q][0][e] & 0xffffu) + w1 * bf2f(a[q][1][e] & 0xffffu) + w2 * bf2f(a[q][2][e] & 0xffffu);
                const float v1 = w0 * bf2f(a[q][0][e] >> 16) + w1 * bf2f(a[q][1][e] >> 16) + w2 * bf2f(a[q][2][e] >> 16);
                o[e] = pk2(v0, v1);
            }
            u16* dst = row < S0 ? ao0 + (size_t)row * D : ao1 + (size_t)(row - S0) * D;
            *(u32x4*)(dst + (4 * pass + hh) * 128 + 8 * c) = o;
        }
    }
}

enum { K_PRO = 0, K_FFN1, K_RESID, K_LRUIN, K_L1, K_CARRY, K_L3, K_QKV, K_ATTN, K_MERGE };
__global__ void __launch_bounds__(512, 2) mega(Params p0) {
    extern __shared__ __attribute__((aligned(16))) unsigned char lds_raw[];
    LAS unsigned char* lds = (LAS unsigned char*)lds_raw;
    cg::grid_group grid = cg::this_grid();
    if (threadIdx.x < 19) { const float* const* src = (const float* const*)&p0; ((LAS unsigned long long*)(lds + PTR_OFF))[threadIdx.x] = (unsigned long long)src[threadIdx.x]; }
    unsigned char* ws0 = p0.ws;
    if (threadIdx.x < 4) ((LAS unsigned*)(lds + XBW_OFF))[threadIdx.x] = 0u;
    __syncthreads();
    XcdBarrier bar = xcd_barrier_post((unsigned*)(ws0 + WS_BAR), (volatile XLAS unsigned*)(lds + XBW_OFF));
#ifndef ONLY_KIND
    { PP p{lds + PTR_OFF, ws0}; prologue_x(p); }
#endif
#pragma unroll 1
    for (int ph = 0; ph < NPHASE; ++ph) {
        unsigned zoff = 0; asm volatile("" : "+s"(zoff)); unsigned char* ws = ws0 + zoff;
        const PP p{lds + PTR_OFF, ws};
        u16* xb = (u16*)(ws + WS_XB); float* ssq = (float*)(ws + WS_SSQ);
        int kind;
        if (ph == 0 || ph == 10) kind = K_PRO;
        else if (ph == 1 || ph == 8 || ph == 11 || ph == 20) kind = K_FFN1;
        else if (ph == 3) kind = K_LRUIN;
        else if (ph == 4) kind = K_L1;
        else if (ph == 5) kind = K_CARRY;
        else if (ph == 6) kind = K_L3;
        else if (ph >= 13 && ph <= 18) { const int s3 = (ph - 13) % 3; kind = s3 == 0 ? K_QKV : (s3 == 1 ? K_ATTN : K_MERGE); }
        else kind = K_RESID;
#define PH_A0 (kind == K_PRO ? (ph != 0 ? 1 : 0) : ((kind == K_QKV || kind == K_ATTN || kind == K_MERGE) ? (ph - 13) / 3 : (ph >= 11 ? 1 : 0)))
#define PH_A1 (kind == K_FFN1 ? ((ph == 8 || ph == 20) ? 1 : 0) : (ph == 7 ? 2 : (ph == 19 ? 3 : ((ph == 9 || ph == 21) ? 1 : 0))))

#ifdef ONLY_KIND
        if (kind != ONLY_KIND) continue;
#endif
#ifdef PROBE_DUP
        int nrep = (kind == PROBE_DUP) ? 2 : 1; asm volatile("" : "+v"(nrep)); nrep = __builtin_amdgcn_readfirstlane(nrep);
        for (int rep = 0; rep < nrep; ++rep) {
        int dry = (rep + 1 < nrep) ? 1 : 0; asm volatile("" : "+v"(dry)); dry = __builtin_amdgcn_readfirstlane(dry);
        if (rep) grid.sync();
#else
        const int dry = 0;
#endif
        switch (kind) {
        case K_PRO: { const int a0 = PH_A0;
            convert_weights((LAS float*)lds, p, a0);
        } break;
        case K_FFN1: { const int a1 = PH_A1;
            pg8::Gemm g{xb, (const u16*)(ws + (a1 == 0 ? W_FI0 : W_FI1)), M, 2 * FF, D, 0ll, 1 << 20}; pg8::StaticOrder S; S.init(M, 2 * FF, (int)gridDim.x, (int)blockIdx.x);
            EpiFFN1 E{(u16*)(ws + WS_HID), lds, 0}; fill_rstd(lds, ssq, S, opaque_tid());
#ifdef STAGGER_TICKS
            { const unsigned cls = (blockIdx.x >> 3) & 3u;
              if (cls) { const unsigned long long t0 = __builtin_amdgcn_s_memrealtime(); while (__builtin_amdgcn_s_memrealtime() - t0 < (unsigned long long)(cls * STAGGER_TICKS)) __builtin_amdgcn_s_sleep(8); } }
#endif
            pg8::gemm_phase<EpiFFN1, pg8::StaticOrder, false>(lds, g, S, E, nullptr);
        } break;
        case K_RESID: { const int a0 = PH_A0, a1 = PH_A1;
            pg8::Gemm g; EpiResid E; E.out = p.out(); E.xb = xb; E.ssq = ssq; E.base0 = p.in(0); E.base1 = p.in(1); E.bias = nullptr; E.scale = 1.0f; E.dry = dry; E.first = 0; E.last = (ph == NPHASE - 1);
            if (a1 < 2) { g = pg8::Gemm{(const u16*)(ws + WS_HID), (const u16*)(ws + (a1 == 0 ? W_FO0 : W_FO1)), M, D, FF, 0ll, 1 << 20}; E.scale = 0.5f;
                          if (a0 == 0 && a1 == 0) E.first = 1; }
            else if (a1 == 2) { g = pg8::Gemm{(const u16*)(ws + WS_YB), (const u16*)(ws + W_LRUOUT), M, D, D, 0ll, 1 << 20}; E.bias = p.in(13); }
            else { g = pg8::Gemm{(const u16*)(ws + WS_AO0), (const u16*)(ws + W_WO), M, D, D, (long long)((const unsigned char*)p.out() + OUT_AO1 - (ws + WS_AO0)) - (long long)S0 * D * 2, S0 / 256}; }
            pg8::StaticOrder S; S.init(M, D, (int)gridDim.x, (int)blockIdx.x); S.rev = a1 < 2 ? 1 : 0;
            pg8::gemm_phase<EpiResid, pg8::StaticOrder, false>(lds, g, S, E, nullptr);
        } break;
        case K_LRUIN: {
            pg8::Gemm g{xb, (const u16*)(ws + W_LRUIN), M, 2 * D, D, 0ll, 1 << 20}; pg8::StaticOrder S; S.init(M, 2 * D, (int)gridDim.x, (int)blockIdx.x);
            EpiLruIn E{(u16*)(ws + WS_YB), (u16*)(ws + WS_UB), lds, p.in(6), 0}; fill_rstd(lds, ssq, S, opaque_tid());
            pg8::gemm_phase<EpiLruIn, pg8::StaticOrder, false>(lds, g, S, E, nullptr);
        } break;
        case K_L1: lru_l1(lds, p, dry); break;
        case K_CARRY: lru_carry(p); break;
        case K_L3: lru_l3(p); break;
        case K_QKV: { const int a0 = PH_A0;
            pg8::Gemm g{xb, (const u16*)(ws + W_QKV) + (size_t)a0 * 4608 * D, M, 4608, D, 0ll, 1 << 20}; pg8::StaticOrder S; S.init(M, 4608, (int)gridDim.x, (int)blockIdx.x);
            EpiQKV E{(u16*)(ws + WS_Q), (u16*)(ws + WS_K), (u16*)((unsigned char*)p.out() + OUT_VT), (float*)(ws + WS_NRM), lds, p.in(15), p.in(16), (const float*)(ws + WS_ROPE), 0}; fill_rstd(lds, ssq, S, opaque_tid());
            pg8::gemm_phase<EpiQKV, pg8::StaticOrder, false>(lds, g, S, E, nullptr);
        } break;
        case K_ATTN: attn_phase(lds, p, dry); break;
        case K_MERGE: attn_merge(p, PH_A0); break;
        }
#ifdef PROBE_DUP
        }
#endif
#ifdef PROBE_SYNC2
        grid.sync();
#endif
        if (zoff == 0x7fffffffu) grid.sync();
        if (ph != NPHASE - 1) xcd_barrier(bar);
    }
}

extern "C" void kernel_launch(void* const* d_in, const int* in_sizes, int n_in, void* d_out, int out_size, void* d_ws, size_t ws_size, hipStream_t stream) {
    static int grid_blocks = 0;
    if (grid_blocks == 0) {
        if (n_in != 18 || out_size != M * D || ws_size < WS_END) { fprintf(stderr, "kernel_launch: unexpected shapes (n_in %d out %d ws %zu need %zu)\n", n_in, out_size, ws_size, (size_t)WS_END); grid_blocks = -1; return; }
        int dev = 0, cus = 0, per_cu = 0;
        hipGetDevice(&dev); hipDeviceGetAttribute(&cus, hipDeviceAttributeMultiprocessorCount, dev);
        if (hipFuncSetAttribute((const void*)mega, hipFuncAttributeMaxDynamicSharedMemorySize, LDS_BYTES) != hipSuccess) { fprintf(stderr, "kernel_launch: hipFuncSetAttribute failed\n"); (void)hipGetLastError(); }
        if (hipOccupancyMaxActiveBlocksPerMultiprocessor(&per_cu, (const void*)mega, 512, LDS_BYTES) != hipSuccess || per_cu < 1) { fprintf(stderr, "kernel_launch: occupancy query says %d\n", per_cu); (void)hipGetLastError(); per_cu = 1; }
        grid_blocks = cus;
    }
    if (grid_blocks < 0) return;
    if (hipMemsetAsync((unsigned char*)d_ws + WS_BAR, 0, XCD_BAR_WORDS * 4, stream) != hipSuccess) { fprintf(stderr, "kernel_launch: memset failed\n"); return; }
    Params p{};
    for (int i = 0; i < 18; ++i) p.in[i] = (const float*)d_in[i];
    p.out = (float*)d_out; p.ws = (unsigned char*)d_ws;
    void* args[] = {&p};
    hipError_t e = hipLaunchCooperativeKernel((const void*)mega, dim3(grid_blocks), dim3(512), args, LDS_BYTES, stream);
    if (e != hipSuccess) fprintf(stderr, "cooperative launch failed: %s (grid %d)\n", hipGetErrorString(e), grid_blocks);
}
```

```cpp
#include <hip/hip_runtime.h>
#include <hip/hip_cooperative_groups.h>
#include <cstdio>
namespace cg = cooperative_groups;

namespace pg8 {
#define PG8_LAS __attribute__((address_space(3)))
typedef unsigned short bf16_t;
typedef short bf16x8 __attribute__((ext_vector_type(8)));
typedef float f32x4 __attribute__((ext_vector_type(4)));
typedef unsigned u32x4 __attribute__((ext_vector_type(4)));
constexpr int BM = 256, BK = 64, HALF = 128, HTB = HALF * BK * 2  , STAGE_BYTES = 8 * HTB, NXCD = 8, WGM = 8;

__host__ __device__ __forceinline__ int lds_byte(int r, int c) { const int st = (r >> 4) * 2 + (c >> 5), rr = r & 15, cc = c & 31, ob = rr * 64 + cc * 2; return st * 1024 + (ob ^ (((ob >> 9) & 1) << 5)); }
__host__ __device__ __forceinline__ void stage_rc(int b, int& R, int& C) { const int st = b / 1024, sb = b % 1024, swz = sb ^ (((sb >> 9) & 1) << 5); R = (st >> 1) * 16 + swz / 64; C = (st & 1) * 32 + (swz % 64) / 2; }
__host__ __device__ __forceinline__ int perm32(int rho) { const int n = rho >> 4, i = rho & 15; return 8 * (i >> 2) + 4 * n + (i & 3); }

struct Unit { int pm, pn; };
struct Gemm { const bf16_t* A; const bf16_t* Bt; int M, N, K; long long delta; int split; };

struct StaticOrder {
    int nM, nN, nwg, G, c, rev;
    __host__ __device__ void init(int M, int N, int G_, int c_) { nM = M / BM; nN = N / BM; nwg = nM * nN; G = G_; c = c_; rev = 0; }
    __host__ __device__ bool next(int i, Unit& u) const {
        const long L = (long)i * G + c; if (L >= nwg) return false;
        int wgid = rev ? nwg - 1 - (int)L : (int)L; { const int q = nwg / NXCD, r = nwg % NXCD, xcd = wgid % NXCD, off = wgid / NXCD; wgid = (xcd < r ? xcd * (q + 1) : r * (q + 1) + (xcd - r) * q) + off; }
        const int nig = WGM * nN, gid = wgid / nig, fm = gid * WGM, gsz = (nM - fm) < WGM ? (nM - fm) : WGM;
        u.pm = fm + ((wgid % nig) % gsz); u.pn = (wgid % nig) / gsz; return true;
    }
    __device__ __forceinline__ void a_ready(const Unit&) const {}
    __device__ __forceinline__ void done(const Unit&) const {}
};
__device__ __forceinline__ unsigned cvt_pk_bf16(float lo, float hi) { unsigned r; asm volatile("v_cvt_pk_bf16_f32 %0, %1, %2" : "=v"(r) : "v"(lo), "v"(hi)); return r; }
typedef float f32x2 __attribute__((ext_vector_type(2)));
template <class Epi, class Sched, bool STAMP = false>
__device__ __forceinline__ void gemm_phase(PG8_LAS unsigned char* lds, const Gemm g, const Sched& S, const Epi& E, unsigned long long* stamps) {
    int tid_o = threadIdx.x; asm volatile("" : "+v"(tid_o));
    const int tid = tid_o, wid = __builtin_amdgcn_readfirstlane(tid >> 6), lane = tid & 63, wr = wid >> 2, wc = wid & 3, fr = lane & 15, fq = lane >> 4;
    const int K = g.K, nt = K / BK;
    int ts_lo = 0, ts_hi = 0, nts = 0; const unsigned long long rt_entry = STAMP ? (unsigned long long)wall_clock64() : 0ull;
#define PG8_STAMP() do { if (STAMP && wid == 0 && nts < 64) { const unsigned long long _c = (unsigned long long)clock64(); \
        ts_lo = (lane == nts) ? (int)(unsigned)_c : ts_lo; ts_hi = (lane == nts) ? (int)(unsigned)(_c >> 32) : ts_hi; ++nts; } } while (0)
    PG8_STAMP();
    unsigned voffA[2], voffB[2];
#pragma unroll
    for (int i = 0; i < 2; ++i) { int R, C; stage_rc(tid * 16 + i * 8192, R, C); const int Rb = Epi::PERM ? ((R & ~31) + perm32(R & 31)) : R;
        voffA[i] = (unsigned)(R * K + C) * 2u; voffB[i] = (unsigned)(Rb * K + C) * 2u; }
    const size_t kstep = (size_t)(BK * 2);
    const size_t hstep = (size_t)HALF * K * 2;
    const size_t tstep = 2 * hstep;
    const unsigned ldsw = (unsigned)wid * 1024u;
    const int aoff = lds_byte(wr * 64 + fr, fq * 8), boff = lds_byte(wc * 32 + fr, fq * 8);
#define PG8_SA(b, h) (((b) * 2 + (h)) * HTB)
#define PG8_SB(b, h) ((4 + (b) * 2 + (h)) * HTB)
#define PG8_STAGE(bufoff, gbase, voff) do { _Pragma("unroll") for (int _i = 0; _i < 2; ++_i) \
        __builtin_amdgcn_global_load_lds((const unsigned*)((const char*)(gbase) + (voff)[_i]), (PG8_LAS unsigned*)(lds + (bufoff) + ldsw + _i * 8192), 16, 0, 0); } while (0)
#define PG8_LDA(dst, b, h) do { _Pragma("unroll") for (int m = 0; m < 4; ++m) _Pragma("unroll") for (int k = 0; k < 2; ++k) dst[m][k] = *(const PG8_LAS bf16x8*)(lds + PG8_SA(b, h) + aoff + m * 2048 + k * 1024); } while (0)
#define PG8_LDB(dst, b, h) do { _Pragma("unroll") for (int n = 0; n < 2; ++n) _Pragma("unroll") for (int k = 0; k < 2; ++k) dst[n][k] = *(const PG8_LAS bf16x8*)(lds + PG8_SB(b, h) + boff + n * 2048 + k * 1024); } while (0)
#define PG8_MMA(ai, bj, At, Bt) do { __builtin_amdgcn_s_setprio(1); _Pragma("unroll") for (int m = 0; m < 4; ++m) _Pragma("unroll") for (int n = 0; n < 2; ++n) _Pragma("unroll") for (int k = 0; k < 2; ++k) \
        acc[ai][bj][m][n] = __builtin_amdgcn_mfma_f32_16x16x32_bf16(Bt[n][k], At[m][k], acc[ai][bj][m][n], 0, 0, 0); __builtin_amdgcn_s_setprio(0); } while (0)
#define PG8_WAIT_V(n) asm volatile("s_waitcnt vmcnt(" #n ")" ::: "memory")
#define PG8_WAIT_L(n) asm volatile("s_waitcnt lgkmcnt(" #n ")" ::: "memory")
#define PG8_BAR __builtin_amdgcn_s_barrier()
#define PG8_SCHED __builtin_amdgcn_sched_barrier(0)
    Unit cur, nxt; int ui = 0;
    if (!S.next(0, cur)) return;
    f32x4 acc[2][2][4][2];
#pragma unroll
    for (int a = 0; a < 2; ++a)
#pragma unroll
        for (int b = 0; b < 2; ++b)
#pragma unroll
            for (int m = 0; m < 4; ++m)
#pragma unroll
                for (int n = 0; n < 2; ++n) acc[a][b][m][n] = (f32x4){0.f, 0.f, 0.f, 0.f};
    bf16x8 At[4][2], B0[2][2], B1[2][2];
    const char* cA = ((const char*)g.A + (size_t)cur.pm * tstep + (cur.pm < g.split ? 0ll : g.delta)); const char* cB = (const char*)g.Bt + (size_t)cur.pn * tstep;
    S.a_ready(cur);
    PG8_STAGE(PG8_SB(0, 0), cB, voffB); PG8_STAGE(PG8_SA(0, 0), cA, voffA); PG8_STAGE(PG8_SB(0, 1), cB + hstep, voffB); PG8_STAGE(PG8_SA(0, 1), cA + hstep, voffA);
    if (wr == 1) PG8_BAR;
    PG8_WAIT_V(4); PG8_BAR;
    PG8_STAGE(PG8_SB(1, 0), cB + kstep, voffB); PG8_STAGE(PG8_SA(1, 0), cA + kstep, voffA); PG8_STAGE(PG8_SB(1, 1), cB + hstep + kstep, voffB);
    PG8_WAIT_V(6); PG8_BAR;
    PG8_STAMP();
    for (;;) {
        const bool has_next = S.next(ui + 1, nxt);
        const char* nA = has_next ? ((const char*)g.A + (size_t)nxt.pm * tstep + (nxt.pm < g.split ? 0ll : g.delta)) : cA; const char* nB = has_next ? (const char*)g.Bt + (size_t)nxt.pn * tstep : cB;
        for (int t = 0; t < nt; t += 2) {
            const bool last = (t == nt - 2);
            const char* a1 = cA + (size_t)(t + 1) * kstep;
            const char* a2 = last ? nA : cA + (size_t)(t + 2) * kstep; const char* b2 = last ? nB : cB + (size_t)(t + 2) * kstep;
            const char* a3 = a2 + kstep; const char* b3 = b2 + kstep;
            if (last && has_next) S.a_ready(nxt);
            PG8_LDB(B0, 0, 0); PG8_SCHED; PG8_LDA(At, 0, 0); PG8_STAGE(PG8_SA(1, 1), a1 + hstep, voffA);
            PG8_WAIT_L(8); PG8_BAR; PG8_WAIT_L(0); PG8_MMA(0, 0, At, B0); PG8_BAR; PG8_SCHED;
            PG8_LDB(B1, 0, 1); PG8_STAGE(PG8_SB(0, 0), b2, voffB);
            PG8_BAR; PG8_WAIT_L(0); PG8_MMA(0, 1, At, B1); PG8_BAR;
            PG8_LDA(At, 0, 1); PG8_STAGE(PG8_SA(0, 0), a2, voffA);
            PG8_BAR; PG8_WAIT_L(0); PG8_MMA(1, 0, At, B0); PG8_BAR; PG8_SCHED;
            PG8_STAGE(PG8_SB(0, 1), b2 + hstep, voffB);
            PG8_WAIT_V(6); PG8_BAR; PG8_MMA(1, 1, At, B1); PG8_BAR;
            PG8_LDB(B0, 1, 0); PG8_SCHED; PG8_LDA(At, 1, 0); PG8_STAGE(PG8_SA(0, 1), a2 + hstep, voffA);
            PG8_WAIT_L(8); PG8_BAR; PG8_WAIT_L(0); PG8_MMA(0, 0, At, B0); PG8_BAR; PG8_SCHED;
            PG8_LDB(B1, 1, 1); PG8_STAGE(PG8_SB(1, 0), b3, voffB);
            PG8_BAR; PG8_WAIT_L(0); PG8_MMA(0, 1, At, B1); PG8_BAR;
            PG8_LDA(At, 1, 1); PG8_STAGE(PG8_SA(1, 0), a3, voffA);
            PG8_BAR; PG8_WAIT_L(0); PG8_MMA(1, 0, At, B0); PG8_BAR; PG8_SCHED;
            PG8_STAGE(PG8_SB(1, 1), b3 + hstep, voffB);
            PG8_WAIT_V(6); PG8_BAR; PG8_MMA(1, 1, At, B1); PG8_BAR;
        }
        PG8_STAMP();
        if constexpr (!Epi::AFTER_DRAIN) { E(acc, cur, wr, wc, fr, fq); S.done(cur); }
        PG8_STAMP();
        if (!has_next) break;
#pragma unroll
        for (int a = 0; a < 2; ++a)
#pragma unroll
            for (int b = 0; b < 2; ++b)
#pragma unroll
                for (int m = 0; m < 4; ++m)
#pragma unroll
                    for (int n = 0; n < 2; ++n) acc[a][b][m][n] = (f32x4){0.f, 0.f, 0.f, 0.f};
        cur = nxt; cA = nA; cB = nB; ++ui;
    }
    PG8_WAIT_V(0);
    if (wr == 0) PG8_BAR;
    PG8_BAR;
    if constexpr (Epi::AFTER_DRAIN) { E.fused(acc, cur, wr, wc, fr, fq, lds, wid, lane); S.done(cur); }
    PG8_STAMP();
    if (STAMP && wid == 0) { stamps[lane] = lane < nts ? (((unsigned long long)(unsigned)ts_hi << 32) | (unsigned)ts_lo) : 0ull;
        if (lane == 62) stamps[62] = rt_entry; if (lane == 63) stamps[63] = (unsigned long long)wall_clock64(); }
#undef PG8_STAMP
#undef PG8_SA
#undef PG8_SB
#undef PG8_STAGE
#undef PG8_LDA
#undef PG8_LDB
#undef PG8_MMA
#undef PG8_WAIT_V
#undef PG8_WAIT_L
#undef PG8_BAR
#undef PG8_SCHED
}
}
#define XB_TMO      128
#define XB_XCNT(j)  (256  + 64 * (j))
#define XB_XSUB(j)  (1280 + 64 * (j))
#define XB_XGEN(j)  (2304 + 64 * (j))
#define XB_TOP      3328
#define XB_TOPGEN   3392
#define XCD_BAR_WORDS 3456
#define XB_SPIN_CAP (1u << 18)
#define XLAS __attribute__((address_space(3)))
__device__ __forceinline__ unsigned xb_ld(unsigned* p)              { return __hip_atomic_load(p, __ATOMIC_RELAXED, __HIP_MEMORY_SCOPE_AGENT); }
__device__ __forceinline__ unsigned xb_add(unsigned* p, unsigned v) { return __hip_atomic_fetch_add(p, v, __ATOMIC_RELAXED, __HIP_MEMORY_SCOPE_AGENT); }
__device__ __forceinline__ unsigned xb_xcc_id() { return (unsigned)__builtin_amdgcn_s_getreg((3 << 11) | 20) & 0xFu; }
#define XB_SPIN(cond, bar) do { unsigned _sp = 0; while (cond) { __builtin_amdgcn_s_sleep(1); \
    if ((++_sp & 255u) == 0u) { if (xb_ld(&(bar)[XB_TMO])) break; if (_sp > XB_SPIN_CAP) { atomicAdd(&(bar)[XB_TMO], 1u); break; } } } } while (0)

struct XcdBarrier {
    unsigned* bar; unsigned x;
    volatile XLAS unsigned* st;
};

__device__ __forceinline__ XcdBarrier xcd_barrier_post(unsigned* bar, volatile XLAS unsigned* st) {
    XcdBarrier b; b.bar = bar; b.x = xb_xcc_id(); b.st = st;
    if (threadIdx.x == 0) (void)xb_add(&bar[XB_XCNT(b.x)], 1u);
    return b;
}
__device__ __forceinline__ void xcd_barrier_complete(unsigned* bar, unsigned x, unsigned& nloc, unsigned& nx) {
    const unsigned G = gridDim.x * gridDim.y * gridDim.z;
    unsigned sum, cnt, mine, sp = 0u;
    for (;;) {
        sum = 0u; cnt = 0u; mine = 0u;
#pragma unroll
        for (unsigned j = 0; j < 16; ++j) { const unsigned c = xb_ld(&bar[XB_XCNT(j)]); sum += c; cnt += (c > 0u) ? 1u : 0u; mine = (j == x) ? c : mine; }
        if (sum == G) break;
        __builtin_amdgcn_s_sleep(1);
        if ((++sp & 255u) == 0u) { if (xb_ld(&bar[XB_TMO])) break; if (sp > XB_SPIN_CAP) { atomicAdd(&bar[XB_TMO], 1u); break; } }
    }
    nloc = mine > 0u ? mine : 1u; nx = cnt > 0u ? cnt : 1u;
}

__device__ __forceinline__ void xcd_barrier(const XcdBarrier& b) {
    asm volatile("s_waitcnt vmcnt(0)" ::: "memory");
    __syncthreads();
    if (threadIdx.x == 0) {
        unsigned* bar = b.bar;
        __builtin_amdgcn_s_waitcnt(0);
        unsigned nloc = b.st[0], nx = b.st[1];
        if (nloc == 0u) { xcd_barrier_complete(bar, b.x, nloc, nx); b.st[0] = nloc; b.st[1] = nx; }
        const unsigned old = xb_add(&bar[XB_XSUB(b.x)], 1u);
        const unsigned gen = old / nloc;
        if (old + 1u == (gen + 1u) * nloc) {
            __builtin_amdgcn_fence(__ATOMIC_RELEASE, "agent");
            asm volatile("s_waitcnt vmcnt(0)" ::: "memory");
            const unsigned og = xb_add(&bar[XB_TOP], 1u);
            const unsigned tg = og / nx;
            if (og + 1u == (tg + 1u) * nx) xb_add(&bar[XB_TOPGEN], 1u);
            else XB_SPIN(xb_ld(&bar[XB_TOPGEN]) == tg, bar);
            __builtin_amdgcn_fence(__ATOMIC_ACQUIRE, "agent");
            xb_add(&bar[XB_XGEN(b.x)], 1u);
            asm volatile("s_waitcnt vmcnt(0)" ::: "memory");
        } else {
            XB_SPIN(xb_ld(&bar[XB_XGEN(b.x)]) == gen, bar);
            __builtin_amdgcn_fence(__ATOMIC_ACQUIRE, "agent");
            asm volatile("s_waitcnt vmcnt(0)" ::: "memory");
        }
    }
    __syncthreads();
}


using pg8::f32x4; using pg8::bf16x8; using pg8::u32x4; using pg8::Unit;
typedef unsigned short u16;
typedef unsigned u32x2 __attribute__((ext_vector_type(2)));
typedef float f32x2v __attribute__((ext_vector_type(2)));
typedef __bf16 bfv2 __attribute__((ext_vector_type(2)));
#define LAS PG8_LAS
#define DI __device__ __forceinline__

constexpr int M = 32768, D = 1024, FF = 2816, S0 = 16384, S1 = 2048;
constexpr int RS_OFF = 131072, RS_UNITS = 12, LDS_BYTES = 163840, XBW_OFF = LDS_BYTES - 256, PTR_OFF = XBW_OFF + 16;
constexpr int NPHASE = 22;

constexpr size_t W_FI0 = 0, W_FO0 = 11534336, W_FI1 = 17301504, W_FO1 = 28835840, W_X = 34603008;
constexpr size_t W_LRUIN = W_X, W_GATE = W_X + 4194304, W_LRUOUT = W_X + 5242880;
constexpr size_t W_QKV = W_X, W_WO = W_X + 18874368;
constexpr size_t WS_XB = 55574528, WS_SSQ = WS_XB + 67108864, WS_ROPE = WS_SSQ + 2097152, WS_BIG = WS_ROPE + 8388608;
constexpr size_t WS_HID = WS_BIG;
constexpr size_t WS_YB = WS_BIG, WS_UB = WS_BIG + 67108864, WS_PYB = WS_BIG + 134217728, WS_PYF = WS_XB;
constexpr size_t WS_SUMA = WS_BIG + 201326592, WS_SUMB = WS_SUMA + 2097152, WS_CF = WS_SUMB + 2097152, WS_CB = WS_CF + 1048576;
constexpr size_t WS_Q = WS_BIG, WS_K = WS_BIG + 100663296, WS_AO0 = WS_BIG + 201326592, OUT_VT = 0, OUT_AO1 = 100663296;
constexpr size_t WS_NRM = 0, WS_LSE = 6291456, WS_BAR = WS_BIG + 234881024, WS_END = WS_BAR + XCD_BAR_WORDS * 4;
static_assert(WS_END <= 369098752, "workspace map exceeds the guaranteed minimum");

struct Params { const float* in[18]; float* out; unsigned char* ws; };
struct PP { LAS const unsigned char* tab; unsigned char* ws;
    __device__ __forceinline__ const float* in(int i) const { const unsigned long long v = *(LAS const unsigned long long*)(tab + 8 * i);
        return (const float*)(__attribute__((address_space(1))) const float*)(((unsigned long long)(unsigned)__builtin_amdgcn_readfirstlane((int)(unsigned)(v >> 32)) << 32) | (unsigned long long)(unsigned)__builtin_amdgcn_readfirstlane((int)(unsigned)v)); }
    __device__ __forceinline__ float* out() const { return (float*)in(18); } };

DI int opaque_tid() { int t = threadIdx.x; asm volatile("" : "+v"(t)); return t; }
#define PIN(x) asm volatile("" : "+v"(x))
DI float bf2f(unsigned b) { return __uint_as_float(b << 16); }
DI unsigned pk2(float a, float b) { bfv2 r = __builtin_convertvector((f32x2v){a, b}, bfv2); return __builtin_bit_cast(unsigned, r); }
DI float sigm(float x) { return __builtin_amdgcn_rcpf(1.0f + __expf(-x)); }
DI float row_rstd(const float* ssq, int row) {
    const f32x4* p = (const f32x4*)(ssq + (size_t)row * 16);
    const f32x4 s = (p[0] + p[1]) + (p[2] + p[3]);
    return __builtin_amdgcn_rsqf(((s[0] + s[1]) + (s[2] + s[3])) * (1.0f / 1024.0f) + 1e-6f);
}

template <class Sched> DI void fill_rstd(LAS unsigned char* lds, const float* ssq, const Sched& S, int tid) {
    LAS float* tab = (LAS float*)(lds + RS_OFF);
#pragma unroll 1
    for (int k0 = 0; k0 < RS_UNITS; k0 += 4) {
        float v[2]; int ok[2];
#pragma unroll
        for (int q = 0; q < 2; ++q) { const int k = k0 + 2 * q + (tid >> 8); Unit u; ok[q] = S.next(k, u) ? 1 : 0; v[q] = ok[q] ? row_rstd(ssq, u.pm * 256 + (tid & 255)) : 0.f; }
#pragma unroll
        for (int q = 0; q < 2; ++q) { const int k = k0 + 2 * q + (tid >> 8); if (ok[q]) tab[k * 256 + (tid & 255)] = v[q]; }
    }
    __syncthreads();
}
DI void wave_rstd(LAS const unsigned char* lds, int k, int wr, int fr, float (&rs)[2][4]) {
    LAS const float* tab = (LAS const float*)(lds + RS_OFF) + k * 256 + wr * 64 + fr;
#pragma unroll
    for (int ai = 0; ai < 2; ++ai)
#pragma unroll
        for (int m = 0; m < 4; ++m) rs[ai][m] = tab[ai * 128 + m * 16];
}
struct EpiFFN1 {
    static constexpr bool PERM = true, AFTER_DRAIN = false;
    u16* hid; LAS const unsigned char* lds; mutable int cnt;
    DI void operator()(const f32x4 (&acc)[2][2][4][2], const Unit& u, int wr, int wc, int fr, int fq) const {
        const int row0 = u.pm * 256 + wr * 64 + fr, col0 = u.pn * 128 + wc * 32 + fq * 8;
        float rsv[2][4]; wave_rstd(lds, cnt, wr, fr, rsv); ++cnt;
#pragma unroll
        for (int ai = 0; ai < 2; ++ai)
#pragma unroll
            for (int m = 0; m < 4; ++m) {
                const int row = row0 + ai * 128 + m * 16; const float rs = rsv[ai][m], nrl = -1.4426950408889634f * rs, rs2 = rs * rs;
                u32x4 w;
#pragma unroll
                for (int n = 0; n < 2; ++n) {
                    const f32x4 g = acc[ai][0][m][n], up = acc[ai][1][m][n];
                    const f32x4 t = g * nrl, gu = (g * up) * rs2;
                    f32x4 ex;
#pragma unroll
                    for (int e = 0; e < 4; ++e) ex[e] = __builtin_amdgcn_exp2f(t[e]);
                    const f32x4 den = ex + 1.0f; f32x4 rc;
#pragma unroll
                    for (int e = 0; e < 4; ++e) rc[e] = __builtin_amdgcn_rcpf(den[e]);
                    const f32x4 h = gu * rc;
                    w[2 * n] = pk2(h[0], h[1]); w[2 * n + 1] = pk2(h[2], h[3]);
                }
#ifdef NT_STORE
                __builtin_nontemporal_store(w, (u32x4*)(hid + (size_t)row * FF + col0));
#else
                *(u32x4*)(hid + (size_t)row * FF + col0) = w;
#endif
            }
    }
};
struct EpiResid {
    static constexpr bool PERM = true, AFTER_DRAIN = false;
    const float* base0; const float* base1; float* out; u16* xb; float* ssq; const float* bias; float scale; int first, last, dry;
    DI void row_out(const f32x4 (&a)[2][2], const f32x4 (&bs)[2][2], int col0, int row, size_t off, int slot, int fq) const {
        float ss = 0.f;
#pragma unroll
        for (int bj = 0; bj < 2; ++bj) {
            const int c = bj * 128;
            f32x4 v0 = bs[bj][0] + a[bj][0] * scale, v1 = bs[bj][1] + a[bj][1] * scale;
            if (bias) { v0 += *(const f32x4*)(bias + col0 + c); v1 += *(const f32x4*)(bias + col0 + c + 4); }
            if (!dry) {
                if (last) { *(f32x4*)(out + off + c) = v0; *(f32x4*)(out + off + c + 4) = v1; }
                else { u32x4 w; w[0] = pk2(v0[0], v0[1]); w[1] = pk2(v0[2], v0[3]); w[2] = pk2(v1[0], v1[1]); w[3] = pk2(v1[2], v1[3]); *(u32x4*)(xb + off + c) = w; }
            }
            ss += (v0[0] * v0[0] + v0[1] * v0[1]) + (v0[2] * v0[2] + v0[3] * v0[3]) + (v1[0] * v1[0] + v1[1] * v1[1]) + (v1[2] * v1[2] + v1[3] * v1[3]);
        }
        ss += __shfl_xor(ss, 16); ss += __shfl_xor(ss, 32);
        if (fq == 0 && !dry) ssq[(size_t)row * 16 + slot] = ss;
    }
    DI void operator()(const f32x4 (&acc)[2][2][4][2], const Unit& u, int wr, int wc, int fr, int fq) const {
        const int row0 = u.pm * 256 + wr * 64 + fr, col0 = u.pn * 256 + wc * 32 + fq * 8, slot = u.pn * 4 + wc;
        if (first) {
#pragma unroll
          for (int ai = 0; ai < 2; ++ai) {
#pragma unroll
                for (int mp = 0; mp < 2; ++mp) {
                    f32x4 bsv[2][2][2];
#pragma unroll
                    for (int mm = 0; mm < 2; ++mm) { const int row = row0 + ai * 128 + (2 * mp + mm) * 16;
                        const float* bp = (row < S0 ? base0 + (size_t)row * D : base1 + (size_t)(row - S0) * D) + col0;
#pragma unroll
                        for (int bj = 0; bj < 2; ++bj) { bsv[mm][bj][0] = *(const f32x4*)(bp + bj * 128); bsv[mm][bj][1] = *(const f32x4*)(bp + bj * 128 + 4); } }
#pragma unroll
                    for (int mm = 0; mm < 2; ++mm) { const int m = 2 * mp + mm; const int row = row0 + ai * 128 + m * 16; const size_t off = (size_t)row * D + col0;
                        f32x4 a[2][2];
#pragma unroll
                        for (int bj = 0; bj < 2; ++bj) { a[bj][0] = acc[ai][bj][m][0]; a[bj][1] = acc[ai][bj][m][1]; }
                        row_out(a, bsv[mm], col0, row, off, slot, fq); }
                    asm volatile("" ::: "memory");
                }
          }
        } else {
            u32x4 raw[2][4][2];
#pragma unroll
            for (int ai = 0; ai < 2; ++ai)
#pragma unroll
                for (int m = 0; m < 4; ++m)
#pragma unroll
                    for (int bj = 0; bj < 2; ++bj) raw[ai][m][bj] = *(const u32x4*)(xb + (size_t)(row0 + ai * 128 + m * 16) * D + col0 + bj * 128);
#pragma unroll
            for (int ai = 0; ai < 2; ++ai)
#pragma unroll
                for (int m = 0; m < 4; ++m) {
                    const int row = row0 + ai * 128 + m * 16; const size_t off = (size_t)row * D + col0;
                    f32x4 bs[2][2], a[2][2];
#pragma unroll
                    for (int bj = 0; bj < 2; ++bj) { const u32x4 r = raw[ai][m][bj];
                        bs[bj][0] = (f32x4){bf2f(r[0] & 0xffffu), bf2f(r[0] >> 16), bf2f(r[1] & 0xffffu), bf2f(r[1] >> 16)};
                        bs[bj][1] = (f32x4){bf2f(r[2] & 0xffffu), bf2f(r[2] >> 16), bf2f(r[3] & 0xffffu), bf2f(r[3] >> 16)};
                        a[bj][0] = acc[ai][bj][m][0]; a[bj][1] = acc[ai][bj][m][1]; }
                    row_out(a, bs, col0, row, off, slot, fq);
                }
        }
    }
};
struct EpiLruIn {
    static constexpr bool PERM = true, AFTER_DRAIN = false;
    u16* yb; u16* ub; LAS const unsigned char* lds; const float* bias; mutable int cnt;
    DI void operator()(const f32x4 (&acc)[2][2][4][2], const Unit& u, int wr, int wc, int fr, int fq) const {
        const int row0 = u.pm * 256 + wr * 64 + fr, colg = u.pn * 256 + wc * 32 + fq * 8;
        const bool isy = u.pn < 4; u16* dst = isy ? yb : ub; const int cb = (u.pn & 3) * 256 + wc * 32 + fq * 8;
        float rsv[2][4]; wave_rstd(lds, cnt, wr, fr, rsv); ++cnt;
        f32x4 bv[2][2];
#pragma unroll
        for (int bj = 0; bj < 2; ++bj)
#pragma unroll
            for (int n = 0; n < 2; ++n) bv[bj][n] = *(const f32x4*)(bias + colg + bj * 128 + n * 4);
#pragma unroll
        for (int ai = 0; ai < 2; ++ai)
#pragma unroll
            for (int m = 0; m < 4; ++m) {
                const int row = row0 + ai * 128 + m * 16; const float rs = rsv[ai][m];
#pragma unroll
                for (int bj = 0; bj < 2; ++bj) {
                    u32x4 w;
#pragma unroll
                    for (int n = 0; n < 2; ++n) {
                        f32x4 v = acc[ai][bj][m][n] * rs + bv[bj][n];
                        if (isy) {
                            const f32x4 z = (v * v * 0.044715f + 1.0f) * v * (-1.5957691216f * 1.4426950408889634f); f32x4 ex;
#pragma unroll
                            for (int e = 0; e < 4; ++e) ex[e] = __builtin_amdgcn_exp2f(z[e]);
                            const f32x4 den = ex + 1.0f; f32x4 rc;
#pragma unroll
                            for (int e = 0; e < 4; ++e) rc[e] = __builtin_amdgcn_rcpf(den[e]);
                            v = v * rc;
                        }
                        w[2 * n] = pk2(v[0], v[1]); w[2 * n + 1] = pk2(v[2], v[3]);
                    }
                    *(u32x4*)(dst + (size_t)row * D + cb + bj * 128) = w;
                }
            }
    }
};
struct EpiQKV {
    static constexpr bool PERM = true, AFTER_DRAIN = false;
    u16* qb; u16* kb; u16* vt; float* nrm; LAS const unsigned char* lds; const float* qgain; const float* kgain; const float* rope; mutable int cnt;
    DI void operator()(const f32x4 (&acc)[2][2][4][2], const Unit& u, int wr, int wc, int fr, int fq) const {
        const int gt = u.pn >> 1, g = gt / 3, t = gt - 3 * g, hh = 2 * (u.pn & 1) + (wc >> 1), dlo = 32 * (wc & 1) + 8 * fq;
        const int row0 = u.pm * 256 + wr * 64 + fr;
        float rsv[2][4]; wave_rstd(lds, cnt, wr, fr, rsv); ++cnt;
        if (t < 2) {
            const float* gain = (t == 0 ? qgain : kgain) + g * 128;
            f32x4 glo[2], ghi[2], rc[2], rsn[2];
#pragma unroll
            for (int n = 0; n < 2; ++n) { glo[n] = *(const f32x4*)(gain + dlo + 4 * n); ghi[n] = *(const f32x4*)(gain + 64 + dlo + 4 * n);
                const f32x4 c0 = *(const f32x4*)(rope + ((size_t)16 * 64 + dlo + 4 * n) * 2), c1 = *(const f32x4*)(rope + ((size_t)16 * 64 + dlo + 4 * n) * 2 + 4);
                rc[n] = (f32x4){c0[0], c0[2], c1[0], c1[2]}; rsn[n] = (f32x4){c0[1], c0[3], c1[1], c1[3]}; }
            u16* dst = (t == 0 ? qb : kb) + (size_t)(g * 4 + hh) * M * 128;
            float* nr = nrm + (size_t)(g * 2 + t) * M * 8;
            f32x4 cs[2], sn[2];
            { const int pos = row0 < S0 ? row0 : ((row0 - S0) & (S1 - 1));
              const f32x4* rp = (const f32x4*)(rope + ((size_t)pos * 64 + dlo) * 2);
#pragma unroll
              for (int n = 0; n < 2; ++n) { const f32x4 c0 = rp[2 * n], c1 = rp[2 * n + 1]; cs[n] = (f32x4){c0[0], c0[2], c1[0], c1[2]}; sn[n] = (f32x4){c0[1], c0[3], c1[1], c1[3]}; } }
#pragma unroll
            for (int ai = 0; ai < 2; ++ai) {
                if (ai == 1) {
#pragma unroll
                    for (int st = 0; st < 5; ++st)
#pragma unroll
                        for (int n = 0; n < 2; ++n) { const f32x4 c2 = cs[n] * rc[n] - sn[n] * rsn[n], s2 = sn[n] * rc[n] + cs[n] * rsn[n]; cs[n] = c2; sn[n] = s2; }
                }
#pragma unroll
                for (int m = 0; m < 4; ++m) {
                    const int row = row0 + ai * 128 + m * 16; const float rs = rsv[ai][m];
                    float ss = 0.f; u32x4 wlo, whi;
#pragma unroll
                    for (int n = 0; n < 2; ++n) {
                        f32x4 lo = acc[ai][0][m][n] * rs, hi = acc[ai][1][m][n] * rs;
                        ss += (lo[0] * lo[0] + lo[1] * lo[1]) + (lo[2] * lo[2] + lo[3] * lo[3]) + (hi[0] * hi[0] + hi[1] * hi[1]) + (hi[2] * hi[2] + hi[3] * hi[3]);
                        lo *= glo[n]; hi *= ghi[n];
                        const f32x4 olo = lo * cs[n] - hi * sn[n], ohi = hi * cs[n] + lo * sn[n];
                        wlo[2 * n] = pk2(olo[0], olo[1]); wlo[2 * n + 1] = pk2(olo[2], olo[3]);
                        whi[2 * n] = pk2(ohi[0], ohi[1]); whi[2 * n + 1] = pk2(ohi[2], ohi[3]);
                        if (m < 3) { const f32x4 c2 = cs[n] * rc[n] - sn[n] * rsn[n], s2 = sn[n] * rc[n] + cs[n] * rsn[n]; cs[n] = c2; sn[n] = s2; }
                    }
                    *(u32x4*)(dst + (size_t)row * 128 + dlo) = wlo;
                    *(u32x4*)(dst + (size_t)row * 128 + 64 + dlo) = whi;
                    ss += __shfl_xor(ss, 16); ss += __shfl_xor(ss, 32);
                    if (fq == 0) nr[(size_t)row * 8 + hh * 2 + (wc & 1)] = ss;
                }
            }
        } else {
            u16* dst = vt + (size_t)(g * 4 + hh) * M * 128;
#pragma unroll
            for (int ai = 0; ai < 2; ++ai)
#pragma unroll
                for (int m = 0; m < 4; ++m) {
                    const int row = row0 + ai * 128 + m * 16; const float rs = rsv[ai][m];
#pragma unroll
                    for (int bj = 0; bj < 2; ++bj) {
                        const f32x4 v0 = acc[ai][bj][m][0] * rs, v1 = acc[ai][bj][m][1] * rs; u32x4 w;
                        w[0] = pk2(v0[0], v0[1]); w[1] = pk2(v0[2], v0[3]); w[2] = pk2(v1[0], v1[1]); w[3] = pk2(v1[2], v1[3]);
                        *(u32x4*)(dst + (size_t)row * 128 + 64 * bj + dlo) = w;
                    }
                }
        }
    }
};

DI int cvt_srccol(int mode, int n0) {
    if (mode == 1) { const int pn = n0 >> 8, c = n0 & 255; return c < 128 ? 128 * pn + c : FF + 128 * pn + (c - 128); }
    if (mode == 2) { const int p = n0 / 4608, rem = n0 - p * 4608, pn = rem >> 8, c = rem & 255, gt = pn >> 1, g = gt / 3, t = gt - 3 * g, hh = (c & 127) >> 6, db = 64 * (c >> 7); return g * 3072 + t * 1024 + (4 * p + 2 * (pn & 1) + hh) * 128 + db; }
    return n0;
}
template <int KT>
DI void cvt_job(LAS float* tile, const float* src, int ld, int K, int Nrows, int mode, const float* gk, u16* dst, int start, int stride) {
    const int tid = opaque_tid(), kt_n = K / KT, items = (Nrows >> 6) * kt_n;
    for (int it = start; it < items; it += stride) {
        const int nt = it / kt_n, kt = it - nt * kt_n, n0 = nt * 64, k0 = kt * KT, c0 = cvt_srccol(mode, n0);
        const int col = tid & 63, kr = tid >> 6;
        float v[KT / 8];
#pragma unroll
        for (int i = 0; i < KT / 8; ++i) v[i] = src[(size_t)(k0 + kr + 8 * i) * ld + c0 + col];
#pragma unroll
        for (int i = 0; i < KT / 8; ++i) { const int k = kr + 8 * i; float x = v[i]; if (gk) x *= gk[k0 + k]; tile[k * 65 + col] = x; }
        __syncthreads();
        const int r = tid >> 3;
#pragma unroll
        for (int j = 0; j < KT / 64; ++j) {
            const int kc = (tid & 7) * 8 + 64 * j; u32x4 w;
#pragma unroll
            for (int q = 0; q < 4; ++q) w[q] = pk2(tile[(kc + 2 * q) * 65 + r], tile[(kc + 2 * q + 1) * 65 + r]);
            *(u32x4*)(dst + (size_t)(n0 + r) * K + k0 + kc) = w;
        }
        __syncthreads();
    }
}
DI void convert_weights(LAS float* tile, const PP& p, int layer) {
    u16* W = (u16*)p.ws; const int G = gridDim.x, b = blockIdx.x;
    const float* ng = p.in(2) + (size_t)layer * 3 * D;
    for (int f = 0; f < 2; ++f) {
        cvt_job<256>(tile, p.in(3) + (size_t)(layer * 2 + f) * D * 2 * FF, 2 * FF, D, 2 * FF, 1, ng + (f == 0 ? 0 : 2 * D), (u16*)(p.ws + (f == 0 ? W_FI0 : W_FI1)), b, G);
        cvt_job<256>(tile, p.in(4) + (size_t)(layer * 2 + f) * FF * D, D, FF, D, 0, nullptr, (u16*)(p.ws + (f == 0 ? W_FO0 : W_FO1)), (b + 64) % G, G);
    }
    if (layer == 0) {
        cvt_job<256>(tile, p.in(5), 2 * D, D, 2 * D, 0, ng + D, (u16*)(p.ws + W_LRUIN), (b + 128) % G, G);
        for (int q = b; q < 32; q += G) cvt_job<64>(tile, p.in(9) + (size_t)q * 16384, 128, 128, 128, 0, nullptr, (u16*)(p.ws + W_GATE) + (size_t)q * 16384, 0, 1);
        cvt_job<256>(tile, p.in(12), D, D, D, 0, nullptr, (u16*)(p.ws + W_LRUOUT), (b + 192) % G, G);
    } else {
        cvt_job<256>(tile, p.in(14), 9216, D, 9216, 2, ng + D, (u16*)(p.ws + W_QKV), (b + 128) % G, G);
        cvt_job<256>(tile, p.in(17), D, D, D, 0, nullptr, (u16*)(p.ws + W_WO), (b + 192) % G, G);
    }
    (void)W;
}
DI void prologue_x(const PP& p) {
    const int tid = opaque_tid(), lane = tid & 63, wave = tid >> 6;
    u16* xb = (u16*)(p.ws + WS_XB); float* ssq = (float*)(p.ws + WS_SSQ);
    for (int row0 = blockIdx.x * 8 + wave; row0 < M; row0 += gridDim.x * 16) {
        f32x4 v[2][4]; int rows[2];
#pragma unroll
        for (int q = 0; q < 2; ++q) { const int row = row0 + q * gridDim.x * 8 < M ? row0 + q * gridDim.x * 8 : row0; rows[q] = row;
            const float* src = row < S0 ? p.in(0) + (size_t)row * D : p.in(1) + (size_t)(row - S0) * D;
#pragma unroll
            for (int i = 0; i < 4; ++i) v[q][i] = *(const f32x4*)(src + i * 256 + lane * 4); }
#pragma unroll
        for (int q = 0; q < 2; ++q) { const int row = rows[q]; float ss = 0.f;
#pragma unroll
            for (int i = 0; i < 4; ++i) { const f32x4 x = v[q][i]; ss += (x[0] * x[0] + x[1] * x[1]) + (x[2] * x[2] + x[3] * x[3]);
                u32x2 w; w.x = pk2(x[0], x[1]); w.y = pk2(x[2], x[3]); *(u32x2*)(xb + (size_t)row * D + i * 256 + lane * 4) = w; }
#pragma unroll
            for (int o = 32; o >= 1; o >>= 1) ss += __shfl_xor(ss, o);
            if (lane < 16) ssq[(size_t)row * 16 + lane] = lane == 0 ? ss : 0.f; }
    }
    f32x2v* tab = (f32x2v*)(p.ws + WS_ROPE);
    for (int idx = blockIdx.x * 512 + tid; idx < S0 * 64; idx += gridDim.x * 512) {
        const int pos = idx >> 6, i = idx & 63;
        const float e = -2.0f * (float)i / 128.0f; const float inv = (float)exp2((double)e * 13.287712379549449);
        const float ang = (float)pos * inv; const double a = (double)ang, nn = rint(a * 0.15915494309189535); const float rf = (float)(a - nn * 6.283185307179586);
        tab[idx] = (f32x2v){cosf(rf), sinf(rf)};
    }
}

constexpr int LT_STRIDE = 272, LT_ROWS = 128, HF_OFF = LT_ROWS * LT_STRIDE, HF_STRIDE = 132, NCHUNK = M / LT_ROWS;
template <int DIR>
DI void lru_dir(LAS unsigned char* lds, const bf16x8 (&Bf)[2][4], float gbr, float gbi, float c8, int wave, int fr, int fq, int row0, int ch,
                u16* yb, u16* pyo, float* sumA, float* sumB, int tt, int dry) {
    LAS const unsigned char* tile = lds; LAS float* hfl = (LAS float*)(lds + HF_OFF);
    const int j = wave * 16 + fr;
    float Arun = 1.f, Brun = 0.f;
    const int oq = DIR ? 3 - fq : fq; const int lane = fq * 16 + fr;
    const int p16 = DIR ? lane + 16 : lane - 16, p32 = DIR ? lane + 32 : lane - 32, ptot = DIR ? fr : fr + 48;
    unsigned short ycur[4];
    { const int mt0 = DIR ? LT_ROWS / 16 - 1 : 0;
#pragma unroll
      for (int r = 0; r < 4; ++r) ycur[r] = yb[(unsigned)(row0 + 16 * mt0 + 4 * fq + r) * D + ch]; }
#pragma unroll 1
    for (int it = 0; it < LT_ROWS / 16; ++it) {
        const int mt = DIR ? LT_ROWS / 16 - 1 - it : it;
        unsigned short ynext[4];
        { const int itn = it + 1 < LT_ROWS / 16 ? it + 1 : it; const int mtn = DIR ? LT_ROWS / 16 - 1 - itn : itn;
#pragma unroll
          for (int r = 0; r < 4; ++r) ynext[r] = yb[(unsigned)(row0 + 16 * mtn + 4 * fq + r) * D + ch]; }
        f32x4 dr = {0.f, 0.f, 0.f, 0.f}, di = {0.f, 0.f, 0.f, 0.f};
#pragma unroll
        for (int ks = 0; ks < 4; ++ks) {
            const bf16x8 a = *(LAS const bf16x8*)(tile + (16 * mt + fr) * LT_STRIDE + (32 * ks + 8 * fq) * 2);
            dr = __builtin_amdgcn_mfma_f32_16x16x32_bf16(a, Bf[0][ks], dr, 0, 0, 0);
            di = __builtin_amdgcn_mfma_f32_16x16x32_bf16(a, Bf[1][ks], di, 0, 0, 0);
        }
        float av[4], bv[4];
        {
            f32x4 uc4;
#pragma unroll
            for (int r = 0; r < 4; ++r) uc4[r] = bf2f(*(LAS const u16*)(tile + (16 * mt + 4 * fq + r) * LT_STRIDE + j * 2));
            const f32x4 tr = (dr + gbr) * -1.4426950408889634f, ti = (di + gbi) * -1.4426950408889634f;
            f32x4 er, ei;
#pragma unroll
            for (int r = 0; r < 4; ++r) { er[r] = __builtin_amdgcn_exp2f(tr[r]); ei[r] = __builtin_amdgcn_exp2f(ti[r]); }
            const f32x4 dr1 = er + 1.0f, di1 = ei + 1.0f;
            f32x4 rg, ig;
#pragma unroll
            for (int r = 0; r < 4; ++r) { rg[r] = __builtin_amdgcn_rcpf(dr1[r]); ig[r] = __builtin_amdgcn_rcpf(di1[r]); }
            const f32x4 la = rg * (-1.4426950408889634f * c8);
            f32x4 a4;
#pragma unroll
            for (int r = 0; r < 4; ++r) a4[r] = __builtin_amdgcn_exp2f(la[r]);
            const f32x4 om = 1.0f - a4 * a4, iu = ig * uc4;
            f32x4 sq4;
#pragma unroll
            for (int r = 0; r < 4; ++r) sq4[r] = __builtin_amdgcn_sqrtf(fmaxf(om[r], 0.f));
            const f32x4 b4 = sq4 * iu;
#pragma unroll
            for (int r = 0; r < 4; ++r) { av[r] = a4[r]; bv[r] = b4[r]; }
        }
        float Ap[4], Bp[4];
#pragma unroll
        for (int q = 0; q < 4; ++q) { const int r = DIR ? 3 - q : q; if (q == 0) { Ap[0] = av[r]; Bp[0] = bv[r]; } else { Ap[q] = av[r] * Ap[q - 1]; Bp[q] = av[r] * Bp[q - 1] + bv[r]; } }
        float Ai = Ap[3], Bi = Bp[3];
        { const float pa = __shfl(Ai, p16), pb = __shfl(Bi, p16); if (oq >= 1) { Bi = Ai * pb + Bi; Ai = Ai * pa; } }
        { const float pa = __shfl(Ai, p32), pb = __shfl(Bi, p32); if (oq >= 2) { Bi = Ai * pb + Bi; Ai = Ai * pa; } }
        float ea = __shfl(Ai, p16), eb = __shfl(Bi, p16); if (oq == 0) { ea = 1.f; eb = 0.f; }
        const float ta = __shfl(Ai, ptot), tb = __shfl(Bi, ptot);
        const float Ax = ea * Arun, Bx = ea * Brun + eb;
#pragma unroll
        for (int q = 0; q < 4; ++q) {
            const int r = DIR ? 3 - q : q; const float h = Ap[q] * Bx + Bp[q], P = Ap[q] * Ax;
            const int tok = 16 * mt + 4 * fq + r;
            const unsigned off = (unsigned)(row0 + tok) * D + ch;
            const float y = bf2f(ycur[r]);
            if (DIR == 0) { hfl[tok * HF_STRIDE + j] = h; if (!dry) pyo[off] = (u16)(pk2(P * y, 0.f) & 0xffffu); }
            else { const float hv = (hfl[tok * HF_STRIDE + j] + h) * y; if (!dry) { yb[off] = (u16)(pk2(hv, 0.f) & 0xffffu); pyo[off] = (u16)(pk2(P * y, 0.f) & 0xffffu); } }
        }
        Brun = ta * Brun + tb; Arun = ta * Arun;
#pragma unroll
        for (int r = 0; r < 4; ++r) ycur[r] = ynext[r];
    }
    if (fq == 0 && !dry) { sumA[(size_t)(DIR * NCHUNK + tt) * D + ch] = Arun; sumB[(size_t)(DIR * NCHUNK + tt) * D + ch] = Brun; }
}
DI void lru_l1(LAS unsigned char* lds, const PP& p, int dry) {
    const int tid = opaque_tid(), lane = tid & 63, wave = tid >> 6, fr = lane & 15, fq = lane >> 4;
    const u16* ub = (const u16*)(p.ws + WS_UB); u16* yb = (u16*)(p.ws + WS_YB); u16* pyf = (u16*)p.out();     u16* pyb = (u16*)(p.ws + WS_PYB);
    const u16* wg = (const u16*)(p.ws + W_GATE); float* sumA = (float*)(p.ws + WS_SUMA); float* sumB = (float*)(p.ws + WS_SUMB);
    const float* conv_w = p.in(7); const float* conv_b = p.in(8);
    for (int unit = blockIdx.x; unit < NCHUNK * 8; unit += gridDim.x) {
        const int tt = unit >> 3, n = unit & 7, row0 = tt * LT_ROWS;
        const int sbase = row0 < S0 ? 0 : S0 + ((row0 - S0) & ~(S1 - 1)), send = sbase + (row0 < S0 ? S0 : S1);
        bf16x8 BfA[2][2][4]; float gbv[2][2], lamv[2];
        { const int j = wave * 16 + fr;
#pragma unroll
          for (int dd = 0; dd < 2; ++dd) {
#pragma unroll
            for (int gg = 0; gg < 2; ++gg) {
#pragma unroll
                for (int ks = 0; ks < 4; ++ks) BfA[dd][gg][ks] = *(const bf16x8*)(wg + ((size_t)((dd * 2 + gg) * 8 + n) * 128 + j) * 128 + 32 * ks + 8 * fq);
                gbv[dd][gg] = p.in(10)[((dd * 2 + gg) * 8 + n) * 128 + j]; }
            lamv[dd] = p.in(11)[dd * D + n * 128 + j]; } }
        {
            const int c = tid & 15, ch8 = n * 128 + c * 8;
            float w[4][8], cb[8];
#pragma unroll
            for (int k = 0; k < 4; ++k) { const f32x4 a = *(const f32x4*)(conv_w + k * D + ch8), b = *(const f32x4*)(conv_w + k * D + ch8 + 4);
#pragma unroll
                for (int e = 0; e < 4; ++e) { w[k][e] = a[e]; w[k][4 + e] = b[e]; } }
            { const f32x4 a = *(const f32x4*)(conv_b + ch8), b = *(const f32x4*)(conv_b + ch8 + 4);
#pragma unroll
                for (int e = 0; e < 4; ++e) { cb[e] = a[e]; cb[4 + e] = b[e]; } }
            u32x4 tap[LT_ROWS / 32][4];
#pragma unroll
            for (int i = 0; i < LT_ROWS / 32; ++i)
#pragma unroll
                for (int k = 0; k < 4; ++k) { const int rr = row0 + (tid >> 4) + 32 * i + k - 2; const int rc = min(max(rr, sbase), send - 1); tap[i][k] = *(const u32x4*)(ub + (size_t)rc * D + ch8); }
#pragma unroll
            for (int i = 0; i < LT_ROWS / 32; ++i) {
                const int r = (tid >> 4) + 32 * i, row = row0 + r; float acc[8];
#pragma unroll
                for (int e = 0; e < 8; ++e) acc[e] = cb[e];
#pragma unroll
                for (int k = 0; k < 4; ++k) { const int rr = row + k - 2; const float in = (rr >= sbase && rr < send) ? 1.0f : 0.0f; const u32x4 v = tap[i][k];
#pragma unroll
                    for (int e = 0; e < 4; ++e) { acc[2 * e] += (w[k][2 * e] * in) * bf2f(v[e] & 0xffffu); acc[2 * e + 1] += (w[k][2 * e + 1] * in) * bf2f(v[e] >> 16); } }
                u32x4 o;
#pragma unroll
                for (int e = 0; e < 4; ++e) o[e] = pk2(acc[2 * e], acc[2 * e + 1]);
                *(LAS u32x4*)(lds + r * LT_STRIDE + c * 16) = o;
            }
        }
        __syncthreads();
        {
            const int ch = n * 128 + wave * 16 + fr;
            float c8v[2];
#pragma unroll
            for (int dd = 0; dd < 2; ++dd) { const float nl = -lamv[dd]; c8v[dd] = 8.0f * (fmaxf(nl, 0.f) + log1pf(expf(-fabsf(nl)))); }
            lru_dir<0>(lds, BfA[0], gbv[0][0], gbv[0][1], c8v[0], wave, fr, fq, row0, ch, yb, pyf, sumA, sumB, tt, dry);
            lru_dir<1>(lds, BfA[1], gbv[1][0], gbv[1][1], c8v[1], wave, fr, fq, row0, ch, yb, pyb, sumA, sumB, tt, dry);
        }
        __syncthreads();
    }
}
DI void lru_carry(const PP& p) {
    const float* sumA = (const float*)(p.ws + WS_SUMA); const float* sumB = (const float*)(p.ws + WS_SUMB);
    float* cF = (float*)(p.ws + WS_CF); float* cB = (float*)(p.ws + WS_CB);
    const int gt = blockIdx.x * 512 + opaque_tid();
    if (gt < 9 * 2 * D) {
        const int ch = gt & (D - 1), d = (gt >> 10) & 1, s = gt >> 11;
        const int t0 = s == 0 ? 0 : 128 + 16 * (s - 1), nt = s == 0 ? 128 : 16; float c = 0.f;
        if (d == 0) {
#pragma unroll 16
            for (int k = 0; k < nt; ++k) { const int tt = t0 + k; cF[(size_t)tt * D + ch] = c; c = sumA[(size_t)tt * D + ch] * c + sumB[(size_t)tt * D + ch]; }
        } else {
#pragma unroll 16
            for (int k = nt - 1; k >= 0; --k) { const int tt = t0 + k; cB[(size_t)tt * D + ch] = c; c = sumA[(size_t)(NCHUNK + tt) * D + ch] * c + sumB[(size_t)(NCHUNK + tt) * D + ch]; }
        }
    }
}
DI void lru_l3(const PP& p) {
    u16* yb = (u16*)(p.ws + WS_YB); const u16* pyf = (const u16*)p.out(); const u16* pyb = (const u16*)(p.ws + WS_PYB);
    const float* cF = (const float*)(p.ws + WS_CF); const float* cB = (const float*)(p.ws + WS_CB);
    const int nth = gridDim.x * 512;
    for (int idx0 = blockIdx.x * 512 + opaque_tid(); idx0 < M * 128; idx0 += 4 * nth) {
        u32x4 h[4], f[4], bb[4]; f32x4 f0[4], f1[4], b0[4], b1[4];
#pragma unroll
        for (int q = 0; q < 4; ++q) {
            int idx = idx0 + q * nth; if (idx >= M * 128) idx = idx0; const int row = idx >> 7, c8 = (idx & 127) * 8, tt = row >> 7; const size_t off = (size_t)row * D + c8;
            h[q] = *(const u32x4*)(yb + off); f[q] = *(const u32x4*)(pyf + off); bb[q] = *(const u32x4*)(pyb + off);
            f0[q] = *(const f32x4*)(cF + (size_t)tt * D + c8); f1[q] = *(const f32x4*)(cF + (size_t)tt * D + c8 + 4);
            b0[q] = *(const f32x4*)(cB + (size_t)tt * D + c8); b1[q] = *(const f32x4*)(cB + (size_t)tt * D + c8 + 4);
        }
#pragma unroll
        for (int q = 0; q < 4; ++q) {
            const int idx = idx0 + q * nth; if (idx >= M * 128) continue; const int row = idx >> 7, c8 = (idx & 127) * 8; const size_t off = (size_t)row * D + c8;
            u32x4 o;
#pragma unroll
            for (int e = 0; e < 4; ++e) {
                const float cf0 = e < 2 ? f0[q][2 * e] : f1[q][2 * e - 4], cf1 = e < 2 ? f0[q][2 * e + 1] : f1[q][2 * e - 3];
                const float cb0 = e < 2 ? b0[q][2 * e] : b1[q][2 * e - 4], cb1 = e < 2 ? b0[q][2 * e + 1] : b1[q][2 * e - 3];
                const float v0 = bf2f(h[q][e] & 0xffffu) + bf2f(f[q][e] & 0xffffu) * cf0 + bf2f(bb[q][e] & 0xffffu) * cb0;
                const float v1 = bf2f(h[q][e] >> 16) + bf2f(f[q][e] >> 16) * cf1 + bf2f(bb[q][e] >> 16) * cb1;
                o[e] = pk2(v0, v1);
            }
            *(u32x4*)(yb + off) = o;
        }
    }
}

constexpr int AK_STRIDE = 272, AK_ROWS = 272, AV_OFF = AK_ROWS * AK_STRIDE, AV_STRIDE = 288, ARK_OFF = AV_OFF + AK_ROWS * AV_STRIDE, NSU = 12 * (M / 128);
static_assert(ARK_OFF + AK_ROWS * 4 <= XBW_OFF, "attention LDS image must stay below the barrier words");
template <int TP, int DH> DI void tr8(unsigned base, u32x2 (&v)[8]) {
    asm volatile(
        "ds_read_b64_tr_b16 %0, %8 offset:%9\n\tds_read_b64_tr_b16 %1, %8 offset:%10\n\tds_read_b64_tr_b16 %2, %8 offset:%11\n\tds_read_b64_tr_b16 %3, %8 offset:%12\n\t"
        "ds_read_b64_tr_b16 %4, %8 offset:%13\n\tds_read_b64_tr_b16 %5, %8 offset:%14\n\tds_read_b64_tr_b16 %6, %8 offset:%15\n\tds_read_b64_tr_b16 %7, %8 offset:%16\n\ts_waitcnt lgkmcnt(0)"
        : "=&v"(v[0]), "=&v"(v[1]), "=&v"(v[2]), "=&v"(v[3]), "=&v"(v[4]), "=&v"(v[5]), "=&v"(v[6]), "=&v"(v[7])
        : "v"(base), "i"((TP * 32) * AV_STRIDE + (4 * DH + 0) * 32), "i"((TP * 32 + 16) * AV_STRIDE + (4 * DH + 0) * 32), "i"((TP * 32) * AV_STRIDE + (4 * DH + 1) * 32), "i"((TP * 32 + 16) * AV_STRIDE + (4 * DH + 1) * 32),
          "i"((TP * 32) * AV_STRIDE + (4 * DH + 2) * 32), "i"((TP * 32 + 16) * AV_STRIDE + (4 * DH + 2) * 32), "i"((TP * 32) * AV_STRIDE + (4 * DH + 3) * 32), "i"((TP * 32 + 16) * AV_STRIDE + (4 * DH + 3) * 32)
        : "memory");
}
template <int TP> DI void pv_pair(unsigned vbase, const bf16x8 Pf, f32x4 (&O)[8]) {
    { u32x2 v[8]; tr8<TP, 0>(vbase, v);
#pragma unroll
      for (int i = 0; i < 4; ++i) { const u32x4 vw = {v[2 * i].x, v[2 * i].y, v[2 * i + 1].x, v[2 * i + 1].y}; O[i] = __builtin_amdgcn_mfma_f32_16x16x32_bf16(__builtin_bit_cast(bf16x8, vw), Pf, O[i], 0, 0, 0); } }
    { u32x2 v[8]; tr8<TP, 1>(vbase, v);
#pragma unroll
      for (int i = 0; i < 4; ++i) { const u32x4 vw = {v[2 * i].x, v[2 * i].y, v[2 * i + 1].x, v[2 * i + 1].y}; O[4 + i] = __builtin_amdgcn_mfma_f32_16x16x32_bf16(__builtin_bit_cast(bf16x8, vw), Pf, O[4 + i], 0, 0, 0); } }
}
struct AttnGeo { int gh, g, dsh, sbase, L, rho, Q0; };
DI AttnGeo attn_geo(int su) {
    AttnGeo a; a.gh = su >> 8; const int w = su & 255; a.g = a.gh >> 2; a.dsh = 2 * a.g;
    const int lin = (w & 7) * 32 + (w >> 3);
    int nblk, lis; if (lin < 128) { a.sbase = 0; nblk = 128; lis = lin; } else { a.sbase = S0 + ((lin - 128) >> 4) * S1; nblk = 16; lis = (lin - 128) & 15; }
    const int S = lin < 128 ? S0 : S1; a.L = S >> a.dsh;
    const int C = nblk < 32 ? nblk : 32, c = lis / C, within = lis - c * C, d = 1 << a.dsh;
    a.rho = within & (d - 1); a.Q0 = (c * (C >> a.dsh) + (within >> a.dsh)) * 128; return a;
}
struct AttnRegs { u32x4 k[9]; u32x4 v[9]; f32x2v nk; bf16x8 q[4]; f32x2v nq; };
template <bool DOK, bool DOV> DI void attn_issue(const AttnGeo& a, int tid, int wave, int fr, int fq, const u16* qbuf, const u16* kbuf, const u16* vtb, const float* nrm, AttnRegs& R) {
    const u16* Q = qbuf + (size_t)a.gh * M * 128; const u16* K = kbuf + (size_t)a.gh * M * 128; const u16* V = vtb + (size_t)a.gh * M * 128;
    const int hh = a.gh & 3;
    const float* nqp = nrm + (size_t)(a.g * 2 + 0) * M * 8 + hh * 2; const float* nkp = nrm + (size_t)(a.g * 2 + 1) * M * 8 + hh * 2;
#pragma unroll
    for (int i = 0; i < 9; ++i) { const int pc = tid + 512 * i; const int j = min(pc >> 4, AK_ROWS - 1), c = pc & 15;
        const int kc = min(max(a.Q0 - 64 + j, 0), a.L - 1); const size_t ro = (size_t)(a.sbase + (kc << a.dsh) + a.rho) * 128 + 8 * c;
        if (DOK) R.k[i] = *(const u32x4*)(K + ro); if (DOV) R.v[i] = *(const u32x4*)(V + ro); }
    if (!DOK) return;
    { const int j = min(tid, AK_ROWS - 1); const int kc = min(max(a.Q0 - 64 + j, 0), a.L - 1); R.nk = *(const f32x2v*)(nkp + (size_t)(a.sbase + (kc << a.dsh) + a.rho) * 8); }
    { const size_t qrow = (size_t)(a.sbase + ((a.Q0 + 16 * wave + fr) << a.dsh) + a.rho);
#pragma unroll
      for (int ks = 0; ks < 4; ++ks) R.q[ks] = *(const bf16x8*)(Q + qrow * 128 + 32 * ks + 8 * fq);
      R.nq = *(const f32x2v*)(nqp + qrow * 8); }
}
DI void attn_phase(LAS unsigned char* lds, const PP& p, int gh_lo, int gh_hi, int mergepass) {
    const int tid = opaque_tid(), lane = tid & 63, wave = tid >> 6, fr = lane & 15, fq = lane >> 4;
    u16* qbuf = (u16*)(p.ws + WS_Q); const u16* kbuf = (const u16*)(p.ws + WS_K); const u16* vtb = (const u16*)((const unsigned char*)p.out() + OUT_VT);
    const float* nrm = (const float*)(p.ws + WS_NRM); float* lse = (float*)(p.ws + WS_LSE);
    const int G = gridDim.x;
    int su = gh_lo * 256 + blockIdx.x; const int su_end = gh_hi * 256;
    AttnRegs R;
    if (su < su_end) { const AttnGeo a0 = attn_geo(su); attn_issue<true, true>(a0, tid, wave, fr, fq, qbuf, kbuf, vtb, nrm, R); }
    while (su < su_end) {
        const AttnGeo a = attn_geo(su);
#pragma unroll
        for (int i = 0; i < 9; ++i) { const int pc = tid + 512 * i; if (pc < AK_ROWS * 16) *(LAS u32x4*)(lds + (pc >> 4) * AK_STRIDE + (pc & 15) * 16) = R.k[i]; }
#pragma unroll
        for (int i = 0; i < 9; ++i) { const int pc = tid + 512 * i; if (pc < AK_ROWS * 16) *(LAS u32x4*)(lds + AV_OFF + (pc >> 4) * AV_STRIDE + (pc & 15) * 16) = R.v[i]; }
        if (tid < AK_ROWS) *(LAS float*)(lds + ARK_OFF + tid * 4) = __builtin_amdgcn_rsqf((R.nk.x + R.nk.y) * (1.0f / 128.0f) + 1e-6f);
        bf16x8 Qf[4];
#pragma unroll
        for (int ks = 0; ks < 4; ++ks) Qf[ks] = R.q[ks];
        const float sq = __builtin_amdgcn_rsqf((R.nq.x + R.nq.y) * (1.0f / 128.0f) + 1e-6f) * 0.08838834764831845f;
        __syncthreads();
        const int nxt = su + G;
        int tidl = tid; asm volatile("" : "+v"(tidl));
        if (nxt < su_end) { const AttnGeo an = attn_geo(nxt); attn_issue<true, false>(an, tidl, tidl >> 6, tidl & 15, (tidl >> 4) & 3, qbuf, kbuf, vtb, nrm, R); }
        f32x4 Sc[9];
        const int jw = 16 * wave;
#pragma unroll
        for (int T = 0; T < 9; ++T) {
            f32x4 acc = {0.f, 0.f, 0.f, 0.f};
#pragma unroll
            for (int ks = 0; ks < 4; ++ks) { const bf16x8 kf = *(LAS const bf16x8*)(lds + (jw + 16 * T + fr) * AK_STRIDE + (32 * ks + 8 * fq) * 2);
                acc = __builtin_amdgcn_mfma_f32_16x16x32_bf16(kf, Qf[ks], acc, 0, 0, 0); }
            const f32x4 rk = *(LAS const f32x4*)(lds + ARK_OFF + (jw + 16 * T + 4 * fq) * 4);
#pragma unroll
            for (int r = 0; r < 4; ++r) {
                const int dd = 16 * T + 4 * fq + r - 64 - fr, kk = a.Q0 + jw + fr + dd;
                const bool ok = dd <= 64 && dd >= -64 && kk >= 0 && kk < a.L;
                Sc[T][r] = ok ? acc[r] * sq * rk[r] : -1e30f;
            }
        }
        float mx = -1e30f;
#pragma unroll
        for (int T = 0; T < 9; ++T)
#pragma unroll
            for (int r = 0; r < 4; ++r) mx = fmaxf(mx, Sc[T][r]);
        mx = fmaxf(mx, __shfl_xor(mx, 16)); mx = fmaxf(mx, __shfl_xor(mx, 32));
        float sum = 0.f;
#pragma unroll
        for (int T = 0; T < 9; ++T)
#pragma unroll
            for (int r = 0; r < 4; ++r) { const float ev = __expf(Sc[T][r] - mx); Sc[T][r] = ev; sum += ev; }
        sum += __shfl_xor(sum, 16); sum += __shfl_xor(sum, 32);
        const float linv = 1.0f / sum, lsev = mx + __logf(sum);
        if (nxt < su_end) { const AttnGeo an = attn_geo(nxt); attn_issue<false, true>(an, tidl, tidl >> 6, tidl & 15, (tidl >> 4) & 3, qbuf, kbuf, vtb, nrm, R); }
        f32x4 O[8];
#pragma unroll
        for (int dt = 0; dt < 8; ++dt) O[dt] = (f32x4){0.f, 0.f, 0.f, 0.f};
        {
            const unsigned vbase = (unsigned)(size_t)lds + AV_OFF + (jw + 4 * fq + (fr >> 2)) * AV_STRIDE + 8 * (fr & 3);
#define PFRAG(tp_, hi_) ({ u32x4 w_; w_[0] = pk2(Sc[2 * (tp_)][0], Sc[2 * (tp_)][1]); w_[1] = pk2(Sc[2 * (tp_)][2], Sc[2 * (tp_)][3]); \
            if (hi_) { w_[2] = pk2(Sc[(hi_) ? 2 * (tp_) + 1 : 0][0], Sc[(hi_) ? 2 * (tp_) + 1 : 0][1]); w_[3] = pk2(Sc[(hi_) ? 2 * (tp_) + 1 : 0][2], Sc[(hi_) ? 2 * (tp_) + 1 : 0][3]); } else { w_[2] = 0u; w_[3] = 0u; } \
            __builtin_bit_cast(bf16x8, w_); })
            pv_pair<0>(vbase, PFRAG(0, 1), O); pv_pair<1>(vbase, PFRAG(1, 1), O); pv_pair<2>(vbase, PFRAG(2, 1), O); pv_pair<3>(vbase, PFRAG(3, 1), O);
            pv_pair<4>(vbase, PFRAG(4, 0), O);
#undef PFRAG
        }
        {
            const size_t qrow = (size_t)(a.sbase + ((a.Q0 + jw + fr) << a.dsh) + a.rho);
            if (mergepass < 0) {
                u16* Q = qbuf + (size_t)a.gh * M * 128;
#pragma unroll
                for (int dt = 0; dt < 8; ++dt) { const f32x4 o = O[dt] * linv; u32x2 w; w.x = pk2(o[0], o[1]); w.y = pk2(o[2], o[3]); *(u32x2*)(Q + qrow * 128 + 16 * dt + 4 * fq) = w; }
                if (fq == 0) lse[(size_t)a.gh * M + qrow] = lsev;
            } else {
                const int hh = a.gh & 3;
                const u16* o0p = qbuf + ((size_t)(0 + hh) * M + qrow) * 128 + 4 * fq; const u16* o1p = qbuf + ((size_t)(4 + hh) * M + qrow) * 128 + 4 * fq;
                const float l0 = lse[(size_t)(0 + hh) * M + qrow], l1 = lse[(size_t)(4 + hh) * M + qrow];
                u32x2 a0[8], a1[8];
#pragma unroll
                for (int dt = 0; dt < 8; ++dt) { a0[dt] = *(const u32x2*)(o0p + 16 * dt); a1[dt] = *(const u32x2*)(o1p + 16 * dt); }
                const float mxl = fmaxf(l0, fmaxf(l1, lsev)); float w0 = __expf(l0 - mxl), w1 = __expf(l1 - mxl), w2 = __expf(lsev - mxl);
                const float inv = 1.0f / (w0 + w1 + w2); w0 *= inv; w1 *= inv; w2 *= inv * linv;
                u16* dst = (qrow < (size_t)S0 ? (u16*)(p.ws + WS_AO0) + qrow * D : (u16*)((unsigned char*)p.out() + OUT_AO1) + (qrow - S0) * D) + (4 * mergepass + hh) * 128 + 4 * fq;
#pragma unroll
                for (int dt = 0; dt < 8; ++dt) {
                    const f32x4 o = O[dt];
                    const float v0 = w0 * bf2f(a0[dt].x & 0xffffu) + w1 * bf2f(a1[dt].x & 0xffffu) + w2 * o[0], v1 = w0 * bf2f(a0[dt].x >> 16) + w1 * bf2f(a1[dt].x >> 16) + w2 * o[1];
                    const float v2 = w0 * bf2f(a0[dt].y & 0xffffu) + w1 * bf2f(a1[dt].y & 0xffffu) + w2 * o[2], v3 = w0 * bf2f(a0[dt].y >> 16) + w1 * bf2f(a1[dt].y >> 16) + w2 * o[3];
                    u32x2 w; w.x = pk2(v0, v1); w.y = pk2(v2, v3); *(u32x2*)(dst + 16 * dt) = w;
                }
            }
        }
        __syncthreads();
        su = nxt;
    }
}
DI void attn_merge(const PP& p, int pass) {
    const u16* qbuf = (const u16*)(p.ws + WS_Q); const float* lse = (const float*)(p.ws + WS_LSE);
    u16* ao0 = (u16*)(p.ws + WS_AO0); u16* ao1 = (u16*)((unsigned char*)p.out() + OUT_AO1);
    const int nth = gridDim.x * 512;
    for (int idx0 = blockIdx.x * 512 + opaque_tid(); idx0 < M * 64; idx0 += 2 * nth) {
        float l[2][3]; u32x4 a[2][3];
#pragma unroll
        for (int q = 0; q < 2; ++q) { int idx = idx0 + q * nth; if (idx >= M * 64) idx = idx0; const int c = idx & 15, hh = (idx >> 4) & 3, row = idx >> 6;
#pragma unroll
            for (int g = 0; g < 3; ++g) { l[q][g] = lse[(size_t)(4 * g + hh) * M + row]; a[q][g] = *(const u32x4*)(qbuf + ((size_t)(4 * g + hh) * M + row) * 128 + 8 * c); } }
#pragma unroll
        for (int q = 0; q < 2; ++q) { const int idx = idx0 + q * nth; if (idx >= M * 64) continue; const int c = idx & 15, hh = (idx >> 4) & 3, row = idx >> 6;
            const float mx = fmaxf(l[q][0], fmaxf(l[q][1], l[q][2])); float w0 = __expf(l[q][0] - mx), w1 = __expf(l[q][1] - mx), w2 = __expf(l[q][2] - mx);
            const float inv = 1.0f / (w0 + w1 + w2); w0 *= inv; w1 *= inv; w2 *= inv;
            u32x4 o;
#pragma unroll
            for (int e = 0; e < 4; ++e) {
                const float v0 = w0 * bf2f(a[q][0][e] & 0xffffu) + w1 * bf2f(a[q][1][e] & 0xffffu) + w2 * bf2f(a[q][2][e] & 0xffffu);
                const float v1 = w0 * bf2f(a[q][0][e] >> 16) + w1 * bf2f(a[q][1][e] >> 16) + w2 * bf2f(a[q][2][e] >> 16);
                o[e] = pk2(v0, v1);
            }
            u16* dst = row < S0 ? ao0 + (size_t)row * D : ao1 + (size_t)(row - S0) * D;
            *(u32x4*)(dst + (4 * pass + hh) * 128 + 8 * c) = o;
        }
    }
}

enum { K_PRO = 0, K_FFN1, K_RESID, K_LRUIN, K_L1, K_CARRY, K_L3, K_QKV, K_ATTN, K_MERGE };
__global__ void __launch_bounds__(512, 2) mega(Params p0) {
    extern __shared__ __attribute__((aligned(16))) unsigned char lds_raw[];
    LAS unsigned char* lds = (LAS unsigned char*)lds_raw;
    cg::grid_group grid = cg::this_grid();
    if (threadIdx.x < 19) { const float* const* src = (const float* const*)&p0; ((LAS unsigned long long*)(lds + PTR_OFF))[threadIdx.x] = (unsigned long long)src[threadIdx.x]; }
    unsigned char* ws0 = p0.ws;
    if (threadIdx.x < 4) ((LAS unsigned*)(lds + XBW_OFF))[threadIdx.x] = 0u;
    __syncthreads();
    XcdBarrier bar = xcd_barrier_post((unsigned*)(ws0 + WS_BAR), (volatile XLAS unsigned*)(lds + XBW_OFF));
#ifndef ONLY_KIND
    { PP p{lds + PTR_OFF, ws0}; prologue_x(p); }
#endif
#pragma unroll 1
    for (int ph = 0; ph < NPHASE; ++ph) {
        unsigned zoff = 0; asm volatile("" : "+s"(zoff)); unsigned char* ws = ws0 + zoff;
        const PP p{lds + PTR_OFF, ws};
        u16* xb = (u16*)(ws + WS_XB); float* ssq = (float*)(ws + WS_SSQ);
        int kind;
        if (ph == 0 || ph == 10) kind = K_PRO;
        else if (ph == 1 || ph == 8 || ph == 11 || ph == 20) kind = K_FFN1;
        else if (ph == 3) kind = K_LRUIN;
        else if (ph == 4) kind = K_L1;
        else if (ph == 5) kind = K_CARRY;
        else if (ph == 6) kind = K_L3;
        else if (ph >= 13 && ph <= 18) { const int s3 = (ph - 13) % 3; kind = s3 == 0 ? K_QKV : (s3 == 1 ? K_ATTN : K_MERGE); }
        else kind = K_RESID;
#define PH_A0 (kind == K_PRO ? (ph != 0 ? 1 : 0) : ((kind == K_QKV || kind == K_ATTN || kind == K_MERGE) ? (ph - 13) / 3 : (ph >= 11 ? 1 : 0)))
#define PH_A1 (kind == K_FFN1 ? ((ph == 8 || ph == 20) ? 1 : 0) : (ph == 7 ? 2 : (ph == 19 ? 3 : ((ph == 9 || ph == 21) ? 1 : 0))))

#ifdef ONLY_KIND
        if (kind != ONLY_KIND) continue;
#endif
#ifdef PROBE_DUP
        int nrep = (kind == PROBE_DUP) ? 2 : 1; asm volatile("" : "+v"(nrep)); nrep = __builtin_amdgcn_readfirstlane(nrep);
        for (int rep = 0; rep < nrep; ++rep) {
        int dry = (rep + 1 < nrep) ? 1 : 0; asm volatile("" : "+v"(dry)); dry = __builtin_amdgcn_readfirstlane(dry);
        if (rep) grid.sync();
#else
        const int dry = 0;
#endif
        switch (kind) {
        case K_PRO: { const int a0 = PH_A0;
            convert_weights((LAS float*)lds, p, a0);
        } break;
        case K_FFN1: { const int a1 = PH_A1;
            pg8::Gemm g{xb, (const u16*)(ws + (a1 == 0 ? W_FI0 : W_FI1)), M, 2 * FF, D, 0ll, 1 << 20}; pg8::StaticOrder S; S.init(M, 2 * FF, (int)gridDim.x, (int)blockIdx.x);
            EpiFFN1 E{(u16*)(ws + WS_HID), lds, 0}; fill_rstd(lds, ssq, S, opaque_tid());
#ifdef STAGGER_TICKS
            { const unsigned cls = (blockIdx.x >> 3) & 3u;
              if (cls) { const unsigned long long t0 = __builtin_amdgcn_s_memrealtime(); while (__builtin_amdgcn_s_memrealtime() - t0 < (unsigned long long)(cls * STAGGER_TICKS)) __builtin_amdgcn_s_sleep(8); } }
#endif
            pg8::gemm_phase<EpiFFN1, pg8::StaticOrder, false>(lds, g, S, E, nullptr);
        } break;
        case K_RESID: { const int a0 = PH_A0, a1 = PH_A1;
            pg8::Gemm g; EpiResid E; E.out = p.out(); E.xb = xb; E.ssq = ssq; E.base0 = p.in(0); E.base1 = p.in(1); E.bias = nullptr; E.scale = 1.0f; E.dry = dry; E.first = 0; E.last = (ph == NPHASE - 1);
            if (a1 < 2) { g = pg8::Gemm{(const u16*)(ws + WS_HID), (const u16*)(ws + (a1 == 0 ? W_FO0 : W_FO1)), M, D, FF, 0ll, 1 << 20}; E.scale = 0.5f;
                          if (a0 == 0 && a1 == 0) E.first = 1; }
            else if (a1 == 2) { g = pg8::Gemm{(const u16*)(ws + WS_YB), (const u16*)(ws + W_LRUOUT), M, D, D, 0ll, 1 << 20}; E.bias = p.in(13); }
            else { g = pg8::Gemm{(const u16*)(ws + WS_AO0), (const u16*)(ws + W_WO), M, D, D, (long long)((const unsigned char*)p.out() + OUT_AO1 - (ws + WS_AO0)) - (long long)S0 * D * 2, S0 / 256}; }
            pg8::StaticOrder S; S.init(M, D, (int)gridDim.x, (int)blockIdx.x); S.rev = a1 < 2 ? 1 : 0;
            pg8::gemm_phase<EpiResid, pg8::StaticOrder, false>(lds, g, S, E, nullptr);
        } break;
        case K_LRUIN: {
            pg8::Gemm g{xb, (const u16*)(ws + W_LRUIN), M, 2 * D, D, 0ll, 1 << 20}; pg8::StaticOrder S; S.init(M, 2 * D, (int)gridDim.x, (int)blockIdx.x);
            EpiLruIn E{(u16*)(ws + WS_YB), (u16*)(ws + WS_UB), lds, p.in(6), 0}; fill_rstd(lds, ssq, S, opaque_tid());
            pg8::gemm_phase<EpiLruIn, pg8::StaticOrder, false>(lds, g, S, E, nullptr);
        } break;
        case K_L1: lru_l1(lds, p, dry); break;
        case K_CARRY: lru_carry(p); break;
        case K_L3: lru_l3(p); break;
        case K_QKV: { const int a0 = PH_A0;
            pg8::Gemm g{xb, (const u16*)(ws + W_QKV) + (size_t)a0 * 4608 * D, M, 4608, D, 0ll, 1 << 20}; pg8::StaticOrder S; S.init(M, 4608, (int)gridDim.x, (int)blockIdx.x);
            EpiQKV E{(u16*)(ws + WS_Q), (u16*)(ws + WS_K), (u16*)((unsigned char*)p.out() + OUT_VT), (float*)(ws + WS_NRM), lds, p.in(15), p.in(16), (const float*)(ws + WS_ROPE), 0}; fill_rstd(lds, ssq, S, opaque_tid());
            pg8::gemm_phase<EpiQKV, pg8::StaticOrder, false>(lds, g, S, E, nullptr);
        } break;
        case K_ATTN: case K_MERGE: { const int isb = kind == K_MERGE ? 1 : 0; attn_phase(lds, p, isb ? 8 : 0, isb ? 12 : 8, isb ? PH_A0 : -1); } break;
        }
#ifdef PROBE_DUP
        }
#endif
#ifdef PROBE_SYNC2
        grid.sync();
#endif
        if (zoff == 0x7fffffffu) grid.sync();
        if (ph != NPHASE - 1) xcd_barrier(bar);
    }
}

extern "C" void kernel_launch(void* const* d_in, const int* in_sizes, int n_in, void* d_out, int out_size, void* d_ws, size_t ws_size, hipStream_t stream) {
    static int grid_blocks = 0;
    if (grid_blocks == 0) {
        if (n_in != 18 || out_size != M * D || ws_size < WS_END) { fprintf(stderr, "kernel_launch: unexpected shapes (n_in %d out %d ws %zu need %zu)\n", n_in, out_size, ws_size, (size_t)WS_END); grid_blocks = -1; return; }
        int dev = 0, cus = 0, per_cu = 0;
        hipGetDevice(&dev); hipDeviceGetAttribute(&cus, hipDeviceAttributeMultiprocessorCount, dev);
        if (hipFuncSetAttribute((const void*)mega, hipFuncAttributeMaxDynamicSharedMemorySize, LDS_BYTES) != hipSuccess) { fprintf(stderr, "kernel_launch: hipFuncSetAttribute failed\n"); (void)hipGetLastError(); }
        if (hipOccupancyMaxActiveBlocksPerMultiprocessor(&per_cu, (const void*)mega, 512, LDS_BYTES) != hipSuccess || per_cu < 1) { fprintf(stderr, "kernel_launch: occupancy query says %d\n", per_cu); (void)hipGetLastError(); per_cu = 1; }
        grid_blocks = cus;
    }
    if (grid_blocks < 0) return;
    if (hipMemsetAsync((unsigned char*)d_ws + WS_BAR, 0, XCD_BAR_WORDS * 4, stream) != hipSuccess) { fprintf(stderr, "kernel_launch: memset failed\n"); return; }
    Params p{};
    for (int i = 0; i < 18; ++i) p.in[i] = (const float*)d_in[i];
    p.out = (float*)d_out; p.ws = (unsigned char*)d_ws;
    void* args[] = {&p};
    hipError_t e = hipLaunchCooperativeKernel((const void*)mega, dim3(grid_blocks), dim3(512), args, LDS_BYTES, stream);
    if (e != hipSuccess) fprintf(stderr, "cooperative launch failed: %s (grid %d)\n", hipGetErrorString(e), grid_blocks);
}
```

```cpp
#include <hip/hip_runtime.h>
#include <hip/hip_cooperative_groups.h>
#include <cstdio>
namespace cg = cooperative_groups;

namespace pg8 {
#define PG8_LAS __attribute__((address_space(3)))
typedef unsigned short bf16_t;
typedef short bf16x8 __attribute__((ext_vector_type(8)));
typedef float f32x4 __attribute__((ext_vector_type(4)));
typedef unsigned u32x4 __attribute__((ext_vector_type(4)));
constexpr int BM = 256, BK = 64, HALF = 128, HTB = HALF * BK * 2  , STAGE_BYTES = 8 * HTB, NXCD = 8, WGM = 8;

__host__ __device__ __forceinline__ int lds_byte(int r, int c) { const int st = (r >> 4) * 2 + (c >> 5), rr = r & 15, cc = c & 31, ob = rr * 64 + cc * 2; return st * 1024 + (ob ^ (((ob >> 9) & 1) << 5)); }
__host__ __device__ __forceinline__ void stage_rc(int b, int& R, int& C) { const int st = b / 1024, sb = b % 1024, swz = sb ^ (((sb >> 9) & 1) << 5); R = (st >> 1) * 16 + swz / 64; C = (st & 1) * 32 + (swz % 64) / 2; }
__host__ __device__ __forceinline__ int perm32(int rho) { const int n = rho >> 4, i = rho & 15; return 8 * (i >> 2) + 4 * n + (i & 3); }

struct Unit { int pm, pn; };
struct Gemm { const bf16_t* A; const bf16_t* Bt; int M, N, K; long long delta; int split; };

struct StaticOrder {
    int nM, nN, nwg, G, c, rev;
    __host__ __device__ void init(int M, int N, int G_, int c_) { nM = M / BM; nN = N / BM; nwg = nM * nN; G = G_; c = c_; rev = 0; }
    __host__ __device__ bool next(int i, Unit& u) const {
        const long L = (long)i * G + c; if (L >= nwg) return false;
        int wgid = rev ? nwg - 1 - (int)L : (int)L; { const int q = nwg / NXCD, r = nwg % NXCD, xcd = wgid % NXCD, off = wgid / NXCD; wgid = (xcd < r ? xcd * (q + 1) : r * (q + 1) + (xcd - r) * q) + off; }
        const int nig = WGM * nN, gid = wgid / nig, fm = gid * WGM, gsz = (nM - fm) < WGM ? (nM - fm) : WGM;
        u.pm = fm + ((wgid % nig) % gsz); u.pn = (wgid % nig) / gsz; return true;
    }
    __device__ __forceinline__ void a_ready(const Unit&) const {}
    __device__ __forceinline__ void done(const Unit&) const {}
};
__device__ __forceinline__ unsigned cvt_pk_bf16(float lo, float hi) { unsigned r; asm volatile("v_cvt_pk_bf16_f32 %0, %1, %2" : "=v"(r) : "v"(lo), "v"(hi)); return r; }
typedef float f32x2 __attribute__((ext_vector_type(2)));
template <class Epi, class Sched, bool STAMP = false>
__device__ __forceinline__ void gemm_phase(PG8_LAS unsigned char* lds, const Gemm g, const Sched& S, const Epi& E, unsigned long long* stamps) {
    int tid_o = threadIdx.x; asm volatile("" : "+v"(tid_o));
    const int tid = tid_o, wid = __builtin_amdgcn_readfirstlane(tid >> 6), lane = tid & 63, wr = wid >> 2, wc = wid & 3, fr = lane & 15, fq = lane >> 4;
    const int K = g.K, nt = K / BK;
    int ts_lo = 0, ts_hi = 0, nts = 0; const unsigned long long rt_entry = STAMP ? (unsigned long long)wall_clock64() : 0ull;
#define PG8_STAMP() do { if (STAMP && wid == 0 && nts < 64) { const unsigned long long _c = (unsigned long long)clock64(); \
        ts_lo = (lane == nts) ? (int)(unsigned)_c : ts_lo; ts_hi = (lane == nts) ? (int)(unsigned)(_c >> 32) : ts_hi; ++nts; } } while (0)
    PG8_STAMP();
    unsigned voffA[2], voffB[2];
#pragma unroll
    for (int i = 0; i < 2; ++i) { int R, C; stage_rc(tid * 16 + i * 8192, R, C); const int Rb = Epi::PERM ? ((R & ~31) + perm32(R & 31)) : R;
        voffA[i] = (unsigned)(R * K + C) * 2u; voffB[i] = (unsigned)(Rb * K + C) * 2u; }
    const size_t kstep = (size_t)(BK * 2);
    const size_t hstep = (size_t)HALF * K * 2;
    const size_t tstep = 2 * hstep;
    const unsigned ldsw = (unsigned)wid * 1024u;
    const int aoff = lds_byte(wr * 64 + fr, fq * 8), boff = lds_byte(wc * 32 + fr, fq * 8);
#define PG8_SA(b, h) (((b) * 2 + (h)) * HTB)
#define PG8_SB(b, h) ((4 + (b) * 2 + (h)) * HTB)
#define PG8_STAGE(bufoff, gbase, voff) do { _Pragma("unroll") for (int _i = 0; _i < 2; ++_i) \
        __builtin_amdgcn_global_load_lds((const unsigned*)((const char*)(gbase) + (voff)[_i]), (PG8_LAS unsigned*)(lds + (bufoff) + ldsw + _i * 8192), 16, 0, 0); } while (0)
#define PG8_LDA(dst, b, h) do { _Pragma("unroll") for (int m = 0; m < 4; ++m) _Pragma("unroll") for (int k = 0; k < 2; ++k) dst[m][k] = *(const PG8_LAS bf16x8*)(lds + PG8_SA(b, h) + aoff + m * 2048 + k * 1024); } while (0)
#define PG8_LDB(dst, b, h) do { _Pragma("unroll") for (int n = 0; n < 2; ++n) _Pragma("unroll") for (int k = 0; k < 2; ++k) dst[n][k] = *(const PG8_LAS bf16x8*)(lds + PG8_SB(b, h) + boff + n * 2048 + k * 1024); } while (0)
#define PG8_MMA(ai, bj, At, Bt) do { __builtin_amdgcn_s_setprio(1); _Pragma("unroll") for (int m = 0; m < 4; ++m) _Pragma("unroll") for (int n = 0; n < 2; ++n) _Pragma("unroll") for (int k = 0; k < 2; ++k) \
        acc[ai][bj][m][n] = __builtin_amdgcn_mfma_f32_16x16x32_bf16(Bt[n][k], At[m][k], acc[ai][bj][m][n], 0, 0, 0); __builtin_amdgcn_s_setprio(0); } while (0)
#define PG8_WAIT_V(n) asm volatile("s_waitcnt vmcnt(" #n ")" ::: "memory")
#define PG8_WAIT_L(n) asm volatile("s_waitcnt lgkmcnt(" #n ")" ::: "memory")
#define PG8_BAR __builtin_amdgcn_s_barrier()
#define PG8_SCHED __builtin_amdgcn_sched_barrier(0)
    Unit cur, nxt; int ui = 0;
    if (!S.next(0, cur)) return;
    f32x4 acc[2][2][4][2];
#pragma unroll
    for (int a = 0; a < 2; ++a)
#pragma unroll
        for (int b = 0; b < 2; ++b)
#pragma unroll
            for (int m = 0; m < 4; ++m)
#pragma unroll
                for (int n = 0; n < 2; ++n) acc[a][b][m][n] = (f32x4){0.f, 0.f, 0.f, 0.f};
    bf16x8 At[4][2], B0[2][2], B1[2][2];
    const char* cA = ((const char*)g.A + (size_t)cur.pm * tstep + (cur.pm < g.split ? 0ll : g.delta)); const char* cB = (const char*)g.Bt + (size_t)cur.pn * tstep;
    S.a_ready(cur);
    PG8_STAGE(PG8_SB(0, 0), cB, voffB); PG8_STAGE(PG8_SA(0, 0), cA, voffA); PG8_STAGE(PG8_SB(0, 1), cB + hstep, voffB); PG8_STAGE(PG8_SA(0, 1), cA + hstep, voffA);
    if (wr == 1) PG8_BAR;
    PG8_WAIT_V(4); PG8_BAR;
    PG8_STAGE(PG8_SB(1, 0), cB + kstep, voffB); PG8_STAGE(PG8_SA(1, 0), cA + kstep, voffA); PG8_STAGE(PG8_SB(1, 1), cB + hstep + kstep, voffB);
    PG8_WAIT_V(6); PG8_BAR;
    PG8_STAMP();
    for (;;) {
        const bool has_next = S.next(ui + 1, nxt);
        const char* nA = has_next ? ((const char*)g.A + (size_t)nxt.pm * tstep + (nxt.pm < g.split ? 0ll : g.delta)) : cA; const char* nB = has_next ? (const char*)g.Bt + (size_t)nxt.pn * tstep : cB;
        for (int t = 0; t < nt; t += 2) {
            const bool last = (t == nt - 2);
            const char* a1 = cA + (size_t)(t + 1) * kstep;
            const char* a2 = last ? nA : cA + (size_t)(t + 2) * kstep; const char* b2 = last ? nB : cB + (size_t)(t + 2) * kstep;
            const char* a3 = a2 + kstep; const char* b3 = b2 + kstep;
            if (last && has_next) S.a_ready(nxt);
            PG8_LDB(B0, 0, 0); PG8_SCHED; PG8_LDA(At, 0, 0); PG8_STAGE(PG8_SA(1, 1), a1 + hstep, voffA);
            PG8_WAIT_L(8); PG8_BAR; PG8_WAIT_L(0); PG8_MMA(0, 0, At, B0); PG8_BAR; PG8_SCHED;
            PG8_LDB(B1, 0, 1); PG8_STAGE(PG8_SB(0, 0), b2, voffB);
            PG8_BAR; PG8_WAIT_L(0); PG8_MMA(0, 1, At, B1); PG8_BAR;
            PG8_LDA(At, 0, 1); PG8_STAGE(PG8_SA(0, 0), a2, voffA);
            PG8_BAR; PG8_WAIT_L(0); PG8_MMA(1, 0, At, B0); PG8_BAR; PG8_SCHED;
            PG8_STAGE(PG8_SB(0, 1), b2 + hstep, voffB);
            PG8_WAIT_V(6); PG8_BAR; PG8_MMA(1, 1, At, B1); PG8_BAR;
            PG8_LDB(B0, 1, 0); PG8_SCHED; PG8_LDA(At, 1, 0); PG8_STAGE(PG8_SA(0, 1), a2 + hstep, voffA);
            PG8_WAIT_L(8); PG8_BAR; PG8_WAIT_L(0); PG8_MMA(0, 0, At, B0); PG8_BAR; PG8_SCHED;
            PG8_LDB(B1, 1, 1); PG8_STAGE(PG8_SB(1, 0), b3, voffB);
            PG8_BAR; PG8_WAIT_L(0); PG8_MMA(0, 1, At, B1); PG8_BAR;
            PG8_LDA(At, 1, 1); PG8_STAGE(PG8_SA(1, 0), a3, voffA);
            PG8_BAR; PG8_WAIT_L(0); PG8_MMA(1, 0, At, B0); PG8_BAR; PG8_SCHED;
            PG8_STAGE(PG8_SB(1, 1), b3 + hstep, voffB);
            PG8_WAIT_V(6); PG8_BAR; PG8_MMA(1, 1, At, B1); PG8_BAR;
        }
        PG8_STAMP();
        if constexpr (!Epi::AFTER_DRAIN) { E(acc, cur, wr, wc, fr, fq); S.done(cur); }
        PG8_STAMP();
        if (!has_next) break;
#pragma unroll
        for (int a = 0; a < 2; ++a)
#pragma unroll
            for (int b = 0; b < 2; ++b)
#pragma unroll
                for (int m = 0; m < 4; ++m)
#pragma unroll
                    for (int n = 0; n < 2; ++n) acc[a][b][m][n] = (f32x4){0.f, 0.f, 0.f, 0.f};
        cur = nxt; cA = nA; cB = nB; ++ui;
    }
    PG8_WAIT_V(0);
    if (wr == 0) PG8_BAR;
    PG8_BAR;
    if constexpr (Epi::AFTER_DRAIN) { E.fused(acc, cur, wr, wc, fr, fq, lds, wid, lane); S.done(cur); }
    PG8_STAMP();
    if (STAMP && wid == 0) { stamps[lane] = lane < nts ? (((unsigned long long)(unsigned)ts_hi << 32) | (unsigned)ts_lo) : 0ull;
        if (lane == 62) stamps[62] = rt_entry; if (lane == 63) stamps[63] = (unsigned long long)wall_clock64(); }
#undef PG8_STAMP
#undef PG8_SA
#undef PG8_SB
#undef PG8_STAGE
#undef PG8_LDA
#undef PG8_LDB
#undef PG8_MMA
#undef PG8_WAIT_V
#undef PG8_WAIT_L
#undef PG8_BAR
#undef PG8_SCHED
}
}
#define XB_TMO      128
#define XB_XCNT(j)  (256  + 64 * (j))
#define XB_XSUB(j)  (1280 + 64 * (j))
#define XB_XGEN(j)  (2304 + 64 * (j))
#define XB_TOP      3328
#define XB_TOPGEN   3392
#define XCD_BAR_WORDS 3456
#define XB_SPIN_CAP (1u << 18)
#define XLAS __attribute__((address_space(3)))
__device__ __forceinline__ unsigned xb_ld(unsigned* p)              { return __hip_atomic_load(p, __ATOMIC_RELAXED, __HIP_MEMORY_SCOPE_AGENT); }
__device__ __forceinline__ unsigned xb_add(unsigned* p, unsigned v) { return __hip_atomic_fetch_add(p, v, __ATOMIC_RELAXED, __HIP_MEMORY_SCOPE_AGENT); }
__device__ __forceinline__ unsigned xb_xcc_id() { return (unsigned)__builtin_amdgcn_s_getreg((3 << 11) | 20) & 0xFu; }
#define XB_SPIN(cond, bar) do { unsigned _sp = 0; while (cond) { __builtin_amdgcn_s_sleep(1); \
    if ((++_sp & 255u) == 0u) { if (xb_ld(&(bar)[XB_TMO])) break; if (_sp > XB_SPIN_CAP) { atomicAdd(&(bar)[XB_TMO], 1u); break; } } } } while (0)

struct XcdBarrier {
    unsigned* bar; unsigned x;
    volatile XLAS unsigned* st;
};

__device__ __forceinline__ XcdBarrier xcd_barrier_post(unsigned* bar, volatile XLAS unsigned* st) {
    XcdBarrier b; b.bar = bar; b.x = xb_xcc_id(); b.st = st;
    if (threadIdx.x == 0) (void)xb_add(&bar[XB_XCNT(b.x)], 1u);
    return b;
}
__device__ __forceinline__ void xcd_barrier_complete(unsigned* bar, unsigned x, unsigned& nloc, unsigned& nx) {
    const unsigned G = gridDim.x * gridDim.y * gridDim.z;
    unsigned sum, cnt, mine, sp = 0u;
    for (;;) {
        sum = 0u; cnt = 0u; mine = 0u;
#pragma unroll
        for (unsigned j = 0; j < 16; ++j) { const unsigned c = xb_ld(&bar[XB_XCNT(j)]); sum += c; cnt += (c > 0u) ? 1u : 0u; mine = (j == x) ? c : mine; }
        if (sum == G) break;
        __builtin_amdgcn_s_sleep(1);
        if ((++sp & 255u) == 0u) { if (xb_ld(&bar[XB_TMO])) break; if (sp > XB_SPIN_CAP) { atomicAdd(&bar[XB_TMO], 1u); break; } }
    }
    nloc = mine > 0u ? mine : 1u; nx = cnt > 0u ? cnt : 1u;
}

__device__ __forceinline__ void xcd_barrier(const XcdBarrier& b) {
    asm volatile("s_waitcnt vmcnt(0)" ::: "memory");
    __syncthreads();
    if (threadIdx.x == 0) {
        unsigned* bar = b.bar;
        __builtin_amdgcn_s_waitcnt(0);
        unsigned nloc = b.st[0], nx = b.st[1];
        if (nloc == 0u) { xcd_barrier_complete(bar, b.x, nloc, nx); b.st[0] = nloc; b.st[1] = nx; }
        const unsigned old = xb_add(&bar[XB_XSUB(b.x)], 1u);
        const unsigned gen = old / nloc;
        if (old + 1u == (gen + 1u) * nloc) {
            __builtin_amdgcn_fence(__ATOMIC_RELEASE, "agent");
            asm volatile("s_waitcnt vmcnt(0)" ::: "memory");
            const unsigned og = xb_add(&bar[XB_TOP], 1u);
            const unsigned tg = og / nx;
            if (og + 1u == (tg + 1u) * nx) xb_add(&bar[XB_TOPGEN], 1u);
            else XB_SPIN(xb_ld(&bar[XB_TOPGEN]) == tg, bar);
            __builtin_amdgcn_fence(__ATOMIC_ACQUIRE, "agent");
            xb_add(&bar[XB_XGEN(b.x)], 1u);
            asm volatile("s_waitcnt vmcnt(0)" ::: "memory");
        } else {
            XB_SPIN(xb_ld(&bar[XB_XGEN(b.x)]) == gen, bar);
            __builtin_amdgcn_fence(__ATOMIC_ACQUIRE, "agent");
            asm volatile("s_waitcnt vmcnt(0)" ::: "memory");
        }
    }
    __syncthreads();
}


using pg8::f32x4; using pg8::bf16x8; using pg8::u32x4; using pg8::Unit;
typedef unsigned short u16;
typedef unsigned u32x2 __attribute__((ext_vector_type(2)));
typedef float f32x2v __attribute__((ext_vector_type(2)));
typedef __bf16 bfv2 __attribute__((ext_vector_type(2)));
#define LAS PG8_LAS
#define DI __device__ __forceinline__

constexpr int M = 32768, D = 1024, FF = 2816, S0 = 16384, S1 = 2048;
constexpr int RS_OFF = 131072, RS_UNITS = 12, LDS_BYTES = 163840, XBW_OFF = LDS_BYTES - 256, PTR_OFF = XBW_OFF + 16;
constexpr int NPHASE = 22;

constexpr size_t W_FI0 = 0, W_FO0 = 11534336, W_FI1 = 17301504, W_FO1 = 28835840, W_X = 34603008;
constexpr size_t W_LRUIN = W_X, W_GATE = W_X + 4194304, W_LRUOUT = W_X + 5242880;
constexpr size_t W_QKV = W_X, W_WO = W_X + 18874368;
constexpr size_t WS_XB = 55574528, WS_SSQ = WS_XB + 67108864, WS_ROPE = WS_SSQ + 2097152, WS_BIG = WS_ROPE + 8388608;
constexpr size_t WS_HID = WS_BIG;
constexpr size_t WS_YB = WS_BIG, WS_UB = WS_BIG + 67108864, WS_PYB = WS_BIG + 134217728, WS_PYF = WS_XB;
constexpr size_t WS_SUMA = WS_BIG + 201326592, WS_SUMB = WS_SUMA + 2097152, WS_CF = WS_SUMB + 2097152, WS_CB = WS_CF + 1048576;
constexpr size_t WS_Q = WS_BIG, WS_K = WS_BIG + 100663296, WS_AO0 = WS_BIG + 201326592, OUT_VT = 0, OUT_AO1 = 100663296;
constexpr size_t WS_NRM = 0, WS_LSE = 6291456, WS_BAR = WS_BIG + 234881024, WS_END = WS_BAR + XCD_BAR_WORDS * 4;
static_assert(WS_END <= 369098752, "workspace map exceeds the guaranteed minimum");

struct Params { const float* in[18]; float* out; unsigned char* ws; };
struct PP { LAS const unsigned char* tab; unsigned char* ws;
    __device__ __forceinline__ const float* in(int i) const { const unsigned long long v = *(LAS const unsigned long long*)(tab + 8 * i);
        return (const float*)(__attribute__((address_space(1))) const float*)(((unsigned long long)(unsigned)__builtin_amdgcn_readfirstlane((int)(unsigned)(v >> 32)) << 32) | (unsigned long long)(unsigned)__builtin_amdgcn_readfirstlane((int)(unsigned)v)); }
    __device__ __forceinline__ float* out() const { return (float*)in(18); } };

DI int opaque_tid() { int t = threadIdx.x; asm volatile("" : "+v"(t)); return t; }
#define PIN(x) asm volatile("" : "+v"(x))
DI float bf2f(unsigned b) { return __uint_as_float(b << 16); }
DI unsigned pk2(float a, float b) { bfv2 r = __builtin_convertvector((f32x2v){a, b}, bfv2); return __builtin_bit_cast(unsigned, r); }
DI float sigm(float x) { return __builtin_amdgcn_rcpf(1.0f + __expf(-x)); }
DI float row_rstd(const float* ssq, int row) {
    const f32x4* p = (const f32x4*)(ssq + (size_t)row * 16);
    const f32x4 s = (p[0] + p[1]) + (p[2] + p[3]);
    return __builtin_amdgcn_rsqf(((s[0] + s[1]) + (s[2] + s[3])) * (1.0f / 1024.0f) + 1e-6f);
}

template <class Sched> DI void fill_rstd(LAS unsigned char* lds, const float* ssq, const Sched& S, int tid) {
    LAS float* tab = (LAS float*)(lds + RS_OFF);
#pragma unroll 1
    for (int k0 = 0; k0 < RS_UNITS; k0 += 4) {
        float v[2]; int ok[2];
#pragma unroll
        for (int q = 0; q < 2; ++q) { const int k = k0 + 2 * q + (tid >> 8); Unit u; ok[q] = S.next(k, u) ? 1 : 0; v[q] = ok[q] ? row_rstd(ssq, u.pm * 256 + (tid & 255)) : 0.f; }
#pragma unroll
        for (int q = 0; q < 2; ++q) { const int k = k0 + 2 * q + (tid >> 8); if (ok[q]) tab[k * 256 + (tid & 255)] = v[q]; }
    }
    __syncthreads();
}
DI void wave_rstd(LAS const unsigned char* lds, int k, int wr, int fr, float (&rs)[2][4]) {
    LAS const float* tab = (LAS const float*)(lds + RS_OFF) + k * 256 + wr * 64 + fr;
#pragma unroll
    for (int ai = 0; ai < 2; ++ai)
#pragma unroll
        for (int m = 0; m < 4; ++m) rs[ai][m] = tab[ai * 128 + m * 16];
}
struct EpiFFN1 {
    static constexpr bool PERM = true, AFTER_DRAIN = false;
    u16* hid; LAS const unsigned char* lds; mutable int cnt;
    DI void operator()(const f32x4 (&acc)[2][2][4][2], const Unit& u, int wr, int wc, int fr, int fq) const {
        const int row0 = u.pm * 256 + wr * 64 + fr, col0 = u.pn * 128 + wc * 32 + fq * 8;
        float rsv[2][4]; wave_rstd(lds, cnt, wr, fr, rsv); ++cnt;
#pragma unroll
        for (int ai = 0; ai < 2; ++ai)
#pragma unroll
            for (int m = 0; m < 4; ++m) {
                const int row = row0 + ai * 128 + m * 16; const float rs = rsv[ai][m], nrl = -1.4426950408889634f * rs, rs2 = rs * rs;
                u32x4 w;
#pragma unroll
                for (int n = 0; n < 2; ++n) {
                    const f32x4 g = acc[ai][0][m][n], up = acc[ai][1][m][n];
                    const f32x4 t = g * nrl, gu = (g * up) * rs2;
                    f32x4 ex;
#pragma unroll
                    for (int e = 0; e < 4; ++e) ex[e] = __builtin_amdgcn_exp2f(t[e]);
                    const f32x4 den = ex + 1.0f; f32x4 rc;
#pragma unroll
                    for (int e = 0; e < 4; ++e) rc[e] = __builtin_amdgcn_rcpf(den[e]);
                    const f32x4 h = gu * rc;
                    w[2 * n] = pk2(h[0], h[1]); w[2 * n + 1] = pk2(h[2], h[3]);
                }
#ifdef NT_STORE
                __builtin_nontemporal_store(w, (u32x4*)(hid + (size_t)row * FF + col0));
#else
                *(u32x4*)(hid + (size_t)row * FF + col0) = w;
#endif
            }
    }
};
struct EpiResid {
    static constexpr bool PERM = true, AFTER_DRAIN = false;
    const float* base0; const float* base1; float* out; u16* xb; float* ssq; const float* bias; float scale; int first, last, dry;
    DI void row_out(const f32x4 (&a)[2][2], const f32x4 (&bs)[2][2], int col0, int row, size_t off, int slot, int fq) const {
        float ss = 0.f;
#pragma unroll
        for (int bj = 0; bj < 2; ++bj) {
            const int c = bj * 128;
            f32x4 v0 = bs[bj][0] + a[bj][0] * scale, v1 = bs[bj][1] + a[bj][1] * scale;
            if (bias) { v0 += *(const f32x4*)(bias + col0 + c); v1 += *(const f32x4*)(bias + col0 + c + 4); }
            if (!dry) {
                if (last) { *(f32x4*)(out + off + c) = v0; *(f32x4*)(out + off + c + 4) = v1; }
                else { u32x4 w; w[0] = pk2(v0[0], v0[1]); w[1] = pk2(v0[2], v0[3]); w[2] = pk2(v1[0], v1[1]); w[3] = pk2(v1[2], v1[3]); *(u32x4*)(xb + off + c) = w; }
            }
            ss += (v0[0] * v0[0] + v0[1] * v0[1]) + (v0[2] * v0[2] + v0[3] * v0[3]) + (v1[0] * v1[0] + v1[1] * v1[1]) + (v1[2] * v1[2] + v1[3] * v1[3]);
        }
        ss += __shfl_xor(ss, 16); ss += __shfl_xor(ss, 32);
        if (fq == 0 && !dry) ssq[(size_t)row * 16 + slot] = ss;
    }
    DI void operator()(const f32x4 (&acc)[2][2][4][2], const Unit& u, int wr, int wc, int fr, int fq) const {
        const int row0 = u.pm * 256 + wr * 64 + fr, col0 = u.pn * 256 + wc * 32 + fq * 8, slot = u.pn * 4 + wc;
        if (first) {
#pragma unroll
          for (int ai = 0; ai < 2; ++ai) {
#pragma unroll
                for (int mp = 0; mp < 2; ++mp) {
                    f32x4 bsv[2][2][2];
#pragma unroll
                    for (int mm = 0; mm < 2; ++mm) { const int row = row0 + ai * 128 + (2 * mp + mm) * 16;
                        const float* bp = (row < S0 ? base0 + (size_t)row * D : base1 + (size_t)(row - S0) * D) + col0;
#pragma unroll
                        for (int bj = 0; bj < 2; ++bj) { bsv[mm][bj][0] = *(const f32x4*)(bp + bj * 128); bsv[mm][bj][1] = *(const f32x4*)(bp + bj * 128 + 4); } }
#pragma unroll
                    for (int mm = 0; mm < 2; ++mm) { const int m = 2 * mp + mm; const int row = row0 + ai * 128 + m * 16; const size_t off = (size_t)row * D + col0;
                        f32x4 a[2][2];
#pragma unroll
                        for (int bj = 0; bj < 2; ++bj) { a[bj][0] = acc[ai][bj][m][0]; a[bj][1] = acc[ai][bj][m][1]; }
                        row_out(a, bsv[mm], col0, row, off, slot, fq); }
                    asm volatile("" ::: "memory");
                }
          }
        } else {
            u32x4 raw[2][4][2];
#pragma unroll
            for (int ai = 0; ai < 2; ++ai)
#pragma unroll
                for (int m = 0; m < 4; ++m)
#pragma unroll
                    for (int bj = 0; bj < 2; ++bj) raw[ai][m][bj] = *(const u32x4*)(xb + (size_t)(row0 + ai * 128 + m * 16) * D + col0 + bj * 128);
#pragma unroll
            for (int ai = 0; ai < 2; ++ai)
#pragma unroll
                for (int m = 0; m < 4; ++m) {
                    const int row = row0 + ai * 128 + m * 16; const size_t off = (size_t)row * D + col0;
                    f32x4 bs[2][2], a[2][2];
#pragma unroll
                    for (int bj = 0; bj < 2; ++bj) { const u32x4 r = raw[ai][m][bj];
                        bs[bj][0] = (f32x4){bf2f(r[0] & 0xffffu), bf2f(r[0] >> 16), bf2f(r[1] & 0xffffu), bf2f(r[1] >> 16)};
                        bs[bj][1] = (f32x4){bf2f(r[2] & 0xffffu), bf2f(r[2] >> 16), bf2f(r[3] & 0xffffu), bf2f(r[3] >> 16)};
                        a[bj][0] = acc[ai][bj][m][0]; a[bj][1] = acc[ai][bj][m][1]; }
                    row_out(a, bs, col0, row, off, slot, fq);
                }
        }
    }
};
struct EpiLruIn {
    static constexpr bool PERM = true, AFTER_DRAIN = false;
    u16* yb; u16* ub; LAS const unsigned char* lds; const float* bias; mutable int cnt;
    DI void operator()(const f32x4 (&acc)[2][2][4][2], const Unit& u, int wr, int wc, int fr, int fq) const {
        const int row0 = u.pm * 256 + wr * 64 + fr, colg = u.pn * 256 + wc * 32 + fq * 8;
        const bool isy = u.pn < 4; u16* dst = isy ? yb : ub; const int cb = (u.pn & 3) * 256 + wc * 32 + fq * 8;
        float rsv[2][4]; wave_rstd(lds, cnt, wr, fr, rsv); ++cnt;
        f32x4 bv[2][2];
#pragma unroll
        for (int bj = 0; bj < 2; ++bj)
#pragma unroll
            for (int n = 0; n < 2; ++n) bv[bj][n] = *(const f32x4*)(bias + colg + bj * 128 + n * 4);
#pragma unroll
        for (int ai = 0; ai < 2; ++ai)
#pragma unroll
            for (int m = 0; m < 4; ++m) {
                const int row = row0 + ai * 128 + m * 16; const float rs = rsv[ai][m];
#pragma unroll
                for (int bj = 0; bj < 2; ++bj) {
                    u32x4 w;
#pragma unroll
                    for (int n = 0; n < 2; ++n) {
                        f32x4 v = acc[ai][bj][m][n] * rs + bv[bj][n];
                        if (isy) {
                            const f32x4 z = (v * v * 0.044715f + 1.0f) * v * (-1.5957691216f * 1.4426950408889634f); f32x4 ex;
#pragma unroll
                            for (int e = 0; e < 4; ++e) ex[e] = __builtin_amdgcn_exp2f(z[e]);
                            const f32x4 den = ex + 1.0f; f32x4 rc;
#pragma unroll
                            for (int e = 0; e < 4; ++e) rc[e] = __builtin_amdgcn_rcpf(den[e]);
                            v = v * rc;
                        }
                        w[2 * n] = pk2(v[0], v[1]); w[2 * n + 1] = pk2(v[2], v[3]);
                    }
                    *(u32x4*)(dst + (size_t)row * D + cb + bj * 128) = w;
                }
            }
    }
};
struct EpiQKV {
    static constexpr bool PERM = true, AFTER_DRAIN = false;
    u16* qb; u16* kb; u16* vt; float* nrm; LAS const unsigned char* lds; const float* qgain; const float* kgain; const float* rope; mutable int cnt;
    DI void operator()(const f32x4 (&acc)[2][2][4][2], const Unit& u, int wr, int wc, int fr, int fq) const {
        const int gt = u.pn >> 1, g = gt / 3, t = gt - 3 * g, hh = 2 * (u.pn & 1) + (wc >> 1), dlo = 32 * (wc & 1) + 8 * fq;
        const int row0 = u.pm * 256 + wr * 64 + fr;
        float rsv[2][4]; wave_rstd(lds, cnt, wr, fr, rsv); ++cnt;
        if (t < 2) {
            const float* gain = (t == 0 ? qgain : kgain) + g * 128;
            f32x4 glo[2], ghi[2], rc[2], rsn[2];
#pragma unroll
            for (int n = 0; n < 2; ++n) { glo[n] = *(const f32x4*)(gain + dlo + 4 * n); ghi[n] = *(const f32x4*)(gain + 64 + dlo + 4 * n);
                const f32x4 c0 = *(const f32x4*)(rope + ((size_t)16 * 64 + dlo + 4 * n) * 2), c1 = *(const f32x4*)(rope + ((size_t)16 * 64 + dlo + 4 * n) * 2 + 4);
                rc[n] = (f32x4){c0[0], c0[2], c1[0], c1[2]}; rsn[n] = (f32x4){c0[1], c0[3], c1[1], c1[3]}; }
            u16* dst = (t == 0 ? qb : kb) + (size_t)(g * 4 + hh) * M * 128;
            float* nr = nrm + (size_t)(g * 2 + t) * M * 8;
            f32x4 cs[2], sn[2];
            { const int pos = row0 < S0 ? row0 : ((row0 - S0) & (S1 - 1));
              const f32x4* rp = (const f32x4*)(rope + ((size_t)pos * 64 + dlo) * 2);
#pragma unroll
              for (int n = 0; n < 2; ++n) { const f32x4 c0 = rp[2 * n], c1 = rp[2 * n + 1]; cs[n] = (f32x4){c0[0], c0[2], c1[0], c1[2]}; sn[n] = (f32x4){c0[1], c0[3], c1[1], c1[3]}; } }
#pragma unroll
            for (int ai = 0; ai < 2; ++ai) {
                if (ai == 1) {
#pragma unroll
                    for (int st = 0; st < 5; ++st)
#pragma unroll
                        for (int n = 0; n < 2; ++n) { const f32x4 c2 = cs[n] * rc[n] - sn[n] * rsn[n], s2 = sn[n] * rc[n] + cs[n] * rsn[n]; cs[n] = c2; sn[n] = s2; }
                }
#pragma unroll
                for (int m = 0; m < 4; ++m) {
                    const int row = row0 + ai * 128 + m * 16; const float rs = rsv[ai][m];
                    float ss = 0.f; u32x4 wlo, whi;
#pragma unroll
                    for (int n = 0; n < 2; ++n) {
                        f32x4 lo = acc[ai][0][m][n] * rs, hi = acc[ai][1][m][n] * rs;
                        ss += (lo[0] * lo[0] + lo[1] * lo[1]) + (lo[2] * lo[2] + lo[3] * lo[3]) + (hi[0] * hi[0] + hi[1] * hi[1]) + (hi[2] * hi[2] + hi[3] * hi[3]);
                        lo *= glo[n]; hi *= ghi[n];
                        const f32x4 olo = lo * cs[n] - hi * sn[n], ohi = hi * cs[n] + lo * sn[n];
                        wlo[2 * n] = pk2(olo[0], olo[1]); wlo[2 * n + 1] = pk2(olo[2], olo[3]);
                        whi[2 * n] = pk2(ohi[0], ohi[1]); whi[2 * n + 1] = pk2(ohi[2], ohi[3]);
                        if (m < 3) { const f32x4 c2 = cs[n] * rc[n] - sn[n] * rsn[n], s2 = sn[n] * rc[n] + cs[n] * rsn[n]; cs[n] = c2; sn[n] = s2; }
                    }
                    *(u32x4*)(dst + (size_t)row * 128 + dlo) = wlo;
                    *(u32x4*)(dst + (size_t)row * 128 + 64 + dlo) = whi;
                    ss += __shfl_xor(ss, 16); ss += __shfl_xor(ss, 32);
                    if (fq == 0) nr[(size_t)row * 8 + hh * 2 + (wc & 1)] = ss;
                }
            }
        } else {
            u16* dst = vt + (size_t)(g * 4 + hh) * M * 128;
#pragma unroll
            for (int ai = 0; ai < 2; ++ai)
#pragma unroll
                for (int m = 0; m < 4; ++m) {
                    const int row = row0 + ai * 128 + m * 16; const float rs = rsv[ai][m];
#pragma unroll
                    for (int bj = 0; bj < 2; ++bj) {
                        const f32x4 v0 = acc[ai][bj][m][0] * rs, v1 = acc[ai][bj][m][1] * rs; u32x4 w;
                        w[0] = pk2(v0[0], v0[1]); w[1] = pk2(v0[2], v0[3]); w[2] = pk2(v1[0], v1[1]); w[3] = pk2(v1[2], v1[3]);
                        *(u32x4*)(dst + (size_t)row * 128 + 64 * bj + dlo) = w;
                    }
                }
        }
    }
};

DI int cvt_srccol(int mode, int n0) {
    if (mode == 1) { const int pn = n0 >> 8, c = n0 & 255; return c < 128 ? 128 * pn + c : FF + 128 * pn + (c - 128); }
    if (mode == 2) { const int p = n0 / 4608, rem = n0 - p * 4608, pn = rem >> 8, c = rem & 255, gt = pn >> 1, g = gt / 3, t = gt - 3 * g, hh = (c & 127) >> 6, db = 64 * (c >> 7); return g * 3072 + t * 1024 + (4 * p + 2 * (pn & 1) + hh) * 128 + db; }
    return n0;
}
template <int KT>
DI void cvt_job(LAS float* tile, const float* src, int ld, int K, int Nrows, int mode, const float* gk, u16* dst, int start, int stride) {
    const int tid = opaque_tid(), kt_n = K / KT, items = (Nrows >> 6) * kt_n;
    for (int it = start; it < items; it += stride) {
        const int nt = it / kt_n, kt = it - nt * kt_n, n0 = nt * 64, k0 = kt * KT, c0 = cvt_srccol(mode, n0);
        const int col = tid & 63, kr = tid >> 6;
        float v[KT / 8];
#pragma unroll
        for (int i = 0; i < KT / 8; ++i) v[i] = src[(size_t)(k0 + kr + 8 * i) * ld + c0 + col];
#pragma unroll
        for (int i = 0; i < KT / 8; ++i) { const int k = kr + 8 * i; float x = v[i]; if (gk) x *= gk[k0 + k]; tile[k * 65 + col] = x; }
        __syncthreads();
        const int r = tid >> 3;
#pragma unroll
        for (int j = 0; j < KT / 64; ++j) {
            const int kc = (tid & 7) * 8 + 64 * j; u32x4 w;
#pragma unroll
            for (int q = 0; q < 4; ++q) w[q] = pk2(tile[(kc + 2 * q) * 65 + r], tile[(kc + 2 * q + 1) * 65 + r]);
            *(u32x4*)(dst + (size_t)(n0 + r) * K + k0 + kc) = w;
        }
        __syncthreads();
    }
}
constexpr int CARRY_WGS = 36;
DI void rope_table(const PP& p, int b, int nb) {
    f32x2v* tab = (f32x2v*)(p.ws + WS_ROPE); const int tid = opaque_tid();
    for (int idx = b * 512 + tid; idx < S0 * 64; idx += nb * 512) {
        const int pos = idx >> 6, i = idx & 63;
        const float e = -2.0f * (float)i / 128.0f; const float inv = (float)exp2((double)e * 13.287712379549449);
        const float ang = (float)pos * inv; const double a = (double)ang, nn = rint(a * 0.15915494309189535); const float rf = (float)(a - nn * 6.283185307179586);
        tab[idx] = (f32x2v){cosf(rf), sinf(rf)};
    }
}
DI void convert_ffn10_early(LAS float* tile, const PP& p, int b, int nb) {
    const float* ng = p.in(2) + (size_t)1 * 3 * D;
    cvt_job<256>(tile, p.in(3) + (size_t)(1 * 2 + 0) * D * 2 * FF, 2 * FF, D, 2 * FF, 1, ng, (u16*)(p.ws + W_FI0), b, nb);
    cvt_job<256>(tile, p.in(4) + (size_t)(1 * 2 + 0) * FF * D, D, FF, D, 0, nullptr, (u16*)(p.ws + W_FO0), (b + 64) % nb, nb);
}
DI void convert_weights(LAS float* tile, const PP& p, int layer) {
    u16* W = (u16*)p.ws; const int G = gridDim.x, b = blockIdx.x;
    const float* ng = p.in(2) + (size_t)layer * 3 * D;
    for (int f = (layer == 1 && (int)gridDim.x > 2 * CARRY_WGS) ? 1 : 0; f < 2; ++f) {
        cvt_job<256>(tile, p.in(3) + (size_t)(layer * 2 + f) * D * 2 * FF, 2 * FF, D, 2 * FF, 1, ng + (f == 0 ? 0 : 2 * D), (u16*)(p.ws + (f == 0 ? W_FI0 : W_FI1)), b, G);
        cvt_job<256>(tile, p.in(4) + (size_t)(layer * 2 + f) * FF * D, D, FF, D, 0, nullptr, (u16*)(p.ws + (f == 0 ? W_FO0 : W_FO1)), (b + 64) % G, G);
    }
    if (layer == 0) {
        cvt_job<256>(tile, p.in(5), 2 * D, D, 2 * D, 0, ng + D, (u16*)(p.ws + W_LRUIN), (b + 128) % G, G);
        for (int q = b; q < 32; q += G) cvt_job<64>(tile, p.in(9) + (size_t)q * 16384, 128, 128, 128, 0, nullptr, (u16*)(p.ws + W_GATE) + (size_t)q * 16384, 0, 1);
        cvt_job<256>(tile, p.in(12), D, D, D, 0, nullptr, (u16*)(p.ws + W_LRUOUT), (b + 192) % G, G);
    } else {
        cvt_job<256>(tile, p.in(14), 9216, D, 9216, 2, ng + D, (u16*)(p.ws + W_QKV), (b + 128) % G, G);
        cvt_job<256>(tile, p.in(17), D, D, D, 0, nullptr, (u16*)(p.ws + W_WO), (b + 192) % G, G);
    }
    (void)W;
}
DI void prologue_x(const PP& p) {
    const int tid = opaque_tid(), lane = tid & 63, wave = tid >> 6;
    u16* xb = (u16*)(p.ws + WS_XB); float* ssq = (float*)(p.ws + WS_SSQ);
    for (int row0 = blockIdx.x * 8 + wave; row0 < M; row0 += gridDim.x * 16) {
        f32x4 v[2][4]; int rows[2];
#pragma unroll
        for (int q = 0; q < 2; ++q) { const int row = row0 + q * gridDim.x * 8 < M ? row0 + q * gridDim.x * 8 : row0; rows[q] = row;
            const float* src = row < S0 ? p.in(0) + (size_t)row * D : p.in(1) + (size_t)(row - S0) * D;
#pragma unroll
            for (int i = 0; i < 4; ++i) v[q][i] = *(const f32x4*)(src + i * 256 + lane * 4); }
#pragma unroll
        for (int q = 0; q < 2; ++q) { const int row = rows[q]; float ss = 0.f;
#pragma unroll
            for (int i = 0; i < 4; ++i) { const f32x4 x = v[q][i]; ss += (x[0] * x[0] + x[1] * x[1]) + (x[2] * x[2] + x[3] * x[3]);
                u32x2 w; w.x = pk2(x[0], x[1]); w.y = pk2(x[2], x[3]); *(u32x2*)(xb + (size_t)row * D + i * 256 + lane * 4) = w; }
#pragma unroll
            for (int o = 32; o >= 1; o >>= 1) ss += __shfl_xor(ss, o);
            if (lane < 16) ssq[(size_t)row * 16 + lane] = lane == 0 ? ss : 0.f; }
    }
}

constexpr int LT_STRIDE = 272, LT_ROWS = 128, HF_OFF = LT_ROWS * LT_STRIDE, HF_STRIDE = 132, NCHUNK = M / LT_ROWS;
template <int DIR>
DI void lru_dir(LAS unsigned char* lds, const bf16x8 (&Bf)[2][4], float gbr, float gbi, float c8, int wave, int fr, int fq, int row0, int ch,
                u16* yb, u16* pyo, float* sumA, float* sumB, int tt, int dry) {
    LAS const unsigned char* tile = lds; LAS float* hfl = (LAS float*)(lds + HF_OFF);
    const int j = wave * 16 + fr;
    float Arun = 1.f, Brun = 0.f;
    const int oq = DIR ? 3 - fq : fq; const int lane = fq * 16 + fr;
    const int p16 = DIR ? lane + 16 : lane - 16, p32 = DIR ? lane + 32 : lane - 32, ptot = DIR ? fr : fr + 48;
    unsigned short ycur[4];
    { const int mt0 = DIR ? LT_ROWS / 16 - 1 : 0;
#pragma unroll
      for (int r = 0; r < 4; ++r) ycur[r] = yb[(unsigned)(row0 + 16 * mt0 + 4 * fq + r) * D + ch]; }
#pragma unroll 1
    for (int it = 0; it < LT_ROWS / 16; ++it) {
        const int mt = DIR ? LT_ROWS / 16 - 1 - it : it;
        unsigned short ynext[4];
        { const int itn = it + 1 < LT_ROWS / 16 ? it + 1 : it; const int mtn = DIR ? LT_ROWS / 16 - 1 - itn : itn;
#pragma unroll
          for (int r = 0; r < 4; ++r) ynext[r] = yb[(unsigned)(row0 + 16 * mtn + 4 * fq + r) * D + ch]; }
        f32x4 dr = {0.f, 0.f, 0.f, 0.f}, di = {0.f, 0.f, 0.f, 0.f};
#pragma unroll
        for (int ks = 0; ks < 4; ++ks) {
            const bf16x8 a = *(LAS const bf16x8*)(tile + (16 * mt + fr) * LT_STRIDE + (32 * ks + 8 * fq) * 2);
            dr = __builtin_amdgcn_mfma_f32_16x16x32_bf16(a, Bf[0][ks], dr, 0, 0, 0);
            di = __builtin_amdgcn_mfma_f32_16x16x32_bf16(a, Bf[1][ks], di, 0, 0, 0);
        }
        float av[4], bv[4];
        {
            f32x4 uc4;
#pragma unroll
            for (int r = 0; r < 4; ++r) uc4[r] = bf2f(*(LAS const u16*)(tile + (16 * mt + 4 * fq + r) * LT_STRIDE + j * 2));
            const f32x4 tr = (dr + gbr) * -1.4426950408889634f, ti = (di + gbi) * -1.4426950408889634f;
            f32x4 er, ei;
#pragma unroll
            for (int r = 0; r < 4; ++r) { er[r] = __builtin_amdgcn_exp2f(tr[r]); ei[r] = __builtin_amdgcn_exp2f(ti[r]); }
            const f32x4 dr1 = er + 1.0f, di1 = ei + 1.0f;
            f32x4 rg, ig;
#pragma unroll
            for (int r = 0; r < 4; ++r) { rg[r] = __builtin_amdgcn_rcpf(dr1[r]); ig[r] = __builtin_amdgcn_rcpf(di1[r]); }
            const f32x4 la = rg * (-1.4426950408889634f * c8);
            f32x4 a4;
#pragma unroll
            for (int r = 0; r < 4; ++r) a4[r] = __builtin_amdgcn_exp2f(la[r]);
            const f32x4 om = 1.0f - a4 * a4, iu = ig * uc4;
            f32x4 sq4;
#pragma unroll
            for (int r = 0; r < 4; ++r) sq4[r] = __builtin_amdgcn_sqrtf(fmaxf(om[r], 0.f));
            const f32x4 b4 = sq4 * iu;
#pragma unroll
            for (int r = 0; r < 4; ++r) { av[r] = a4[r]; bv[r] = b4[r]; }
        }
        float Ap[4], Bp[4];
#pragma unroll
        for (int q = 0; q < 4; ++q) { const int r = DIR ? 3 - q : q; if (q == 0) { Ap[0] = av[r]; Bp[0] = bv[r]; } else { Ap[q] = av[r] * Ap[q - 1]; Bp[q] = av[r] * Bp[q - 1] + bv[r]; } }
        float Ai = Ap[3], Bi = Bp[3];
        { const float pa = __shfl(Ai, p16), pb = __shfl(Bi, p16); if (oq >= 1) { Bi = Ai * pb + Bi; Ai = Ai * pa; } }
        { const float pa = __shfl(Ai, p32), pb = __shfl(Bi, p32); if (oq >= 2) { Bi = Ai * pb + Bi; Ai = Ai * pa; } }
        float ea = __shfl(Ai, p16), eb = __shfl(Bi, p16); if (oq == 0) { ea = 1.f; eb = 0.f; }
        const float ta = __shfl(Ai, ptot), tb = __shfl(Bi, ptot);
        const float Ax = ea * Arun, Bx = ea * Brun + eb;
#pragma unroll
        for (int q = 0; q < 4; ++q) {
            const int r = DIR ? 3 - q : q; const float h = Ap[q] * Bx + Bp[q], P = Ap[q] * Ax;
            const int tok = 16 * mt + 4 * fq + r;
            const unsigned off = (unsigned)(row0 + tok) * D + ch;
            const float y = bf2f(ycur[r]);
            if (DIR == 0) { hfl[tok * HF_STRIDE + j] = h; if (!dry) pyo[off] = (u16)(pk2(P * y, 0.f) & 0xffffu); }
            else { const float hv = (hfl[tok * HF_STRIDE + j] + h) * y; if (!dry) { yb[off] = (u16)(pk2(hv, 0.f) & 0xffffu); pyo[off] = (u16)(pk2(P * y, 0.f) & 0xffffu); } }
        }
        Brun = ta * Brun + tb; Arun = ta * Arun;
#pragma unroll
        for (int r = 0; r < 4; ++r) ycur[r] = ynext[r];
    }
    if (fq == 0 && !dry) { sumA[(size_t)(DIR * NCHUNK + tt) * D + ch] = Arun; sumB[(size_t)(DIR * NCHUNK + tt) * D + ch] = Brun; }
}
DI void lru_l1(LAS unsigned char* lds, const PP& p, int dry) {
    const int tid = opaque_tid(), lane = tid & 63, wave = tid >> 6, fr = lane & 15, fq = lane >> 4;
    const u16* ub = (const u16*)(p.ws + WS_UB); u16* yb = (u16*)(p.ws + WS_YB); u16* pyf = (u16*)p.out();     u16* pyb = (u16*)(p.ws + WS_PYB);
    const u16* wg = (const u16*)(p.ws + W_GATE); float* sumA = (float*)(p.ws + WS_SUMA); float* sumB = (float*)(p.ws + WS_SUMB);
    const float* conv_w = p.in(7); const float* conv_b = p.in(8);
    for (int unit = blockIdx.x; unit < NCHUNK * 8; unit += gridDim.x) {
        const int tt = unit >> 3, n = unit & 7, row0 = tt * LT_ROWS;
        const int sbase = row0 < S0 ? 0 : S0 + ((row0 - S0) & ~(S1 - 1)), send = sbase + (row0 < S0 ? S0 : S1);
        bf16x8 BfA[2][2][4]; float gbv[2][2], lamv[2];
        { const int j = wave * 16 + fr;
#pragma unroll
          for (int dd = 0; dd < 2; ++dd) {
#pragma unroll
            for (int gg = 0; gg < 2; ++gg) {
#pragma unroll
                for (int ks = 0; ks < 4; ++ks) BfA[dd][gg][ks] = *(const bf16x8*)(wg + ((size_t)((dd * 2 + gg) * 8 + n) * 128 + j) * 128 + 32 * ks + 8 * fq);
                gbv[dd][gg] = p.in(10)[((dd * 2 + gg) * 8 + n) * 128 + j]; }
            lamv[dd] = p.in(11)[dd * D + n * 128 + j]; } }
        {
            const int c = tid & 15, ch8 = n * 128 + c * 8;
            float w[4][8], cb[8];
#pragma unroll
            for (int k = 0; k < 4; ++k) { const f32x4 a = *(const f32x4*)(conv_w + k * D + ch8), b = *(const f32x4*)(conv_w + k * D + ch8 + 4);
#pragma unroll
                for (int e = 0; e < 4; ++e) { w[k][e] = a[e]; w[k][4 + e] = b[e]; } }
            { const f32x4 a = *(const f32x4*)(conv_b + ch8), b = *(const f32x4*)(conv_b + ch8 + 4);
#pragma unroll
                for (int e = 0; e < 4; ++e) { cb[e] = a[e]; cb[4 + e] = b[e]; } }
            u32x4 tap[LT_ROWS / 32][4];
#pragma unroll
            for (int i = 0; i < LT_ROWS / 32; ++i)
#pragma unroll
                for (int k = 0; k < 4; ++k) { const int rr = row0 + (tid >> 4) + 32 * i + k - 2; const int rc = min(max(rr, sbase), send - 1); tap[i][k] = *(const u32x4*)(ub + (size_t)rc * D + ch8); }
#pragma unroll
            for (int i = 0; i < LT_ROWS / 32; ++i) {
                const int r = (tid >> 4) + 32 * i, row = row0 + r; float acc[8];
#pragma unroll
                for (int e = 0; e < 8; ++e) acc[e] = cb[e];
#pragma unroll
                for (int k = 0; k < 4; ++k) { const int rr = row + k - 2; const float in = (rr >= sbase && rr < send) ? 1.0f : 0.0f; const u32x4 v = tap[i][k];
#pragma unroll
                    for (int e = 0; e < 4; ++e) { acc[2 * e] += (w[k][2 * e] * in) * bf2f(v[e] & 0xffffu); acc[2 * e + 1] += (w[k][2 * e + 1] * in) * bf2f(v[e] >> 16); } }
                u32x4 o;
#pragma unroll
                for (int e = 0; e < 4; ++e) o[e] = pk2(acc[2 * e], acc[2 * e + 1]);
                *(LAS u32x4*)(lds + r * LT_STRIDE + c * 16) = o;
            }
        }
        __syncthreads();
        {
            const int ch = n * 128 + wave * 16 + fr;
            float c8v[2];
#pragma unroll
            for (int dd = 0; dd < 2; ++dd) { const float nl = -lamv[dd]; c8v[dd] = 8.0f * (fmaxf(nl, 0.f) + log1pf(expf(-fabsf(nl)))); }
            lru_dir<0>(lds, BfA[0], gbv[0][0], gbv[0][1], c8v[0], wave, fr, fq, row0, ch, yb, pyf, sumA, sumB, tt, dry);
            lru_dir<1>(lds, BfA[1], gbv[1][0], gbv[1][1], c8v[1], wave, fr, fq, row0, ch, yb, pyb, sumA, sumB, tt, dry);
        }
        __syncthreads();
    }
}
DI void lru_carry(const PP& p) {
    const float* sumA = (const float*)(p.ws + WS_SUMA); const float* sumB = (const float*)(p.ws + WS_SUMB);
    float* cF = (float*)(p.ws + WS_CF); float* cB = (float*)(p.ws + WS_CB);
    const int gt = blockIdx.x * 512 + opaque_tid();
    if (gt < 9 * 2 * D) {
        const int ch = gt & (D - 1), d = (gt >> 10) & 1, s = gt >> 11;
        const int t0 = s == 0 ? 0 : 128 + 16 * (s - 1), nt = s == 0 ? 128 : 16; float c = 0.f;
        if (d == 0) {
#pragma unroll 16
            for (int k = 0; k < nt; ++k) { const int tt = t0 + k; cF[(size_t)tt * D + ch] = c; c = sumA[(size_t)tt * D + ch] * c + sumB[(size_t)tt * D + ch]; }
        } else {
#pragma unroll 16
            for (int k = nt - 1; k >= 0; --k) { const int tt = t0 + k; cB[(size_t)tt * D + ch] = c; c = sumA[(size_t)(NCHUNK + tt) * D + ch] * c + sumB[(size_t)(NCHUNK + tt) * D + ch]; }
        }
    }
}
DI void lru_l3(const PP& p) {
    u16* yb = (u16*)(p.ws + WS_YB); const u16* pyf = (const u16*)p.out(); const u16* pyb = (const u16*)(p.ws + WS_PYB);
    const float* cF = (const float*)(p.ws + WS_CF); const float* cB = (const float*)(p.ws + WS_CB);
    const int nth = gridDim.x * 512;
    for (int idx0 = blockIdx.x * 512 + opaque_tid(); idx0 < M * 128; idx0 += 4 * nth) {
        u32x4 h[4], f[4], bb[4]; f32x4 f0[4], f1[4], b0[4], b1[4];
#pragma unroll
        for (int q = 0; q < 4; ++q) {
            int idx = idx0 + q * nth; if (idx >= M * 128) idx = idx0; const int row = idx >> 7, c8 = (idx & 127) * 8, tt = row >> 7; const size_t off = (size_t)row * D + c8;
            h[q] = *(const u32x4*)(yb + off); f[q] = *(const u32x4*)(pyf + off); bb[q] = *(const u32x4*)(pyb + off);
            f0[q] = *(const f32x4*)(cF + (size_t)tt * D + c8); f1[q] = *(const f32x4*)(cF + (size_t)tt * D + c8 + 4);
            b0[q] = *(const f32x4*)(cB + (size_t)tt * D + c8); b1[q] = *(const f32x4*)(cB + (size_t)tt * D + c8 + 4);
        }
#pragma unroll
        for (int q = 0; q < 4; ++q) {
            const int idx = idx0 + q * nth; if (idx >= M * 128) continue; const int row = idx >> 7, c8 = (idx & 127) * 8; const size_t off = (size_t)row * D + c8;
            u32x4 o;
#pragma unroll
            for (int e = 0; e < 4; ++e) {
                const float cf0 = e < 2 ? f0[q][2 * e] : f1[q][2 * e - 4], cf1 = e < 2 ? f0[q][2 * e + 1] : f1[q][2 * e - 3];
                const float cb0 = e < 2 ? b0[q][2 * e] : b1[q][2 * e - 4], cb1 = e < 2 ? b0[q][2 * e + 1] : b1[q][2 * e - 3];
                const float v0 = bf2f(h[q][e] & 0xffffu) + bf2f(f[q][e] & 0xffffu) * cf0 + bf2f(bb[q][e] & 0xffffu) * cb0;
                const float v1 = bf2f(h[q][e] >> 16) + bf2f(f[q][e] >> 16) * cf1 + bf2f(bb[q][e] >> 16) * cb1;
                o[e] = pk2(v0, v1);
            }
            *(u32x4*)(yb + off) = o;
        }
    }
}

constexpr int AK_STRIDE = 272, AK_ROWS = 272, AV_OFF = AK_ROWS * AK_STRIDE, AV_STRIDE = 288, ARK_OFF = AV_OFF + AK_ROWS * AV_STRIDE, NSU = 12 * (M / 128);
static_assert(ARK_OFF + AK_ROWS * 4 <= XBW_OFF, "attention LDS image must stay below the barrier words");
template <int TP, int DH> DI void tr8(unsigned base, u32x2 (&v)[8]) {
    asm volatile(
        "ds_read_b64_tr_b16 %0, %8 offset:%9\n\tds_read_b64_tr_b16 %1, %8 offset:%10\n\tds_read_b64_tr_b16 %2, %8 offset:%11\n\tds_read_b64_tr_b16 %3, %8 offset:%12\n\t"
        "ds_read_b64_tr_b16 %4, %8 offset:%13\n\tds_read_b64_tr_b16 %5, %8 offset:%14\n\tds_read_b64_tr_b16 %6, %8 offset:%15\n\tds_read_b64_tr_b16 %7, %8 offset:%16\n\ts_waitcnt lgkmcnt(0)"
        : "=&v"(v[0]), "=&v"(v[1]), "=&v"(v[2]), "=&v"(v[3]), "=&v"(v[4]), "=&v"(v[5]), "=&v"(v[6]), "=&v"(v[7])
        : "v"(base), "i"((TP * 32) * AV_STRIDE + (4 * DH + 0) * 32), "i"((TP * 32 + 16) * AV_STRIDE + (4 * DH + 0) * 32), "i"((TP * 32) * AV_STRIDE + (4 * DH + 1) * 32), "i"((TP * 32 + 16) * AV_STRIDE + (4 * DH + 1) * 32),
          "i"((TP * 32) * AV_STRIDE + (4 * DH + 2) * 32), "i"((TP * 32 + 16) * AV_STRIDE + (4 * DH + 2) * 32), "i"((TP * 32) * AV_STRIDE + (4 * DH + 3) * 32), "i"((TP * 32 + 16) * AV_STRIDE + (4 * DH + 3) * 32)
        : "memory");
}
template <int TP> DI void pv_pair(unsigned vbase, const bf16x8 Pf, f32x4 (&O)[8]) {
    { u32x2 v[8]; tr8<TP, 0>(vbase, v);
#pragma unroll
      for (int i = 0; i < 4; ++i) { const u32x4 vw = {v[2 * i].x, v[2 * i].y, v[2 * i + 1].x, v[2 * i + 1].y}; O[i] = __builtin_amdgcn_mfma_f32_16x16x32_bf16(__builtin_bit_cast(bf16x8, vw), Pf, O[i], 0, 0, 0); } }
    { u32x2 v[8]; tr8<TP, 1>(vbase, v);
#pragma unroll
      for (int i = 0; i < 4; ++i) { const u32x4 vw = {v[2 * i].x, v[2 * i].y, v[2 * i + 1].x, v[2 * i + 1].y}; O[4 + i] = __builtin_amdgcn_mfma_f32_16x16x32_bf16(__builtin_bit_cast(bf16x8, vw), Pf, O[4 + i], 0, 0, 0); } }
}
struct AttnGeo { int gh, g, dsh, sbase, L, rho, Q0; };
DI AttnGeo attn_geo(int su) {
    AttnGeo a; a.gh = su >> 8; const int w = su & 255; a.g = a.gh >> 2; a.dsh = 2 * a.g;
    const int lin = (w & 7) * 32 + (w >> 3);
    int nblk, lis; if (lin < 128) { a.sbase = 0; nblk = 128; lis = lin; } else { a.sbase = S0 + ((lin - 128) >> 4) * S1; nblk = 16; lis = (lin - 128) & 15; }
    const int S = lin < 128 ? S0 : S1; a.L = S >> a.dsh;
    const int C = nblk < 32 ? nblk : 32, c = lis / C, within = lis - c * C, d = 1 << a.dsh;
    a.rho = within & (d - 1); a.Q0 = (c * (C >> a.dsh) + (within >> a.dsh)) * 128; return a;
}
struct AttnRegs { u32x4 k[9]; u32x4 v[9]; f32x2v nk; bf16x8 q[4]; f32x2v nq; };
template <bool DOK, bool DOV> DI void attn_issue(const AttnGeo& a, int tid, int wave, int fr, int fq, const u16* qbuf, const u16* kbuf, const u16* vtb, const float* nrm, AttnRegs& R) {
    const u16* Q = qbuf + (size_t)a.gh * M * 128; const u16* K = kbuf + (size_t)a.gh * M * 128; const u16* V = vtb + (size_t)a.gh * M * 128;
    const int hh = a.gh & 3;
    const float* nqp = nrm + (size_t)(a.g * 2 + 0) * M * 8 + hh * 2; const float* nkp = nrm + (size_t)(a.g * 2 + 1) * M * 8 + hh * 2;
#pragma unroll
    for (int i = 0; i < 9; ++i) { const int pc = tid + 512 * i; const int j = min(pc >> 4, AK_ROWS - 1), c = pc & 15;
        const int kc = min(max(a.Q0 - 64 + j, 0), a.L - 1); const size_t ro = (size_t)(a.sbase + (kc << a.dsh) + a.rho) * 128 + 8 * c;
        if (DOK) R.k[i] = *(const u32x4*)(K + ro); if (DOV) R.v[i] = *(const u32x4*)(V + ro); }
    if (!DOK) return;
    { const int j = min(tid, AK_ROWS - 1); const int kc = min(max(a.Q0 - 64 + j, 0), a.L - 1); R.nk = *(const f32x2v*)(nkp + (size_t)(a.sbase + (kc << a.dsh) + a.rho) * 8); }
    { const size_t qrow = (size_t)(a.sbase + ((a.Q0 + 16 * wave + fr) << a.dsh) + a.rho);
#pragma unroll
      for (int ks = 0; ks < 4; ++ks) R.q[ks] = *(const bf16x8*)(Q + qrow * 128 + 32 * ks + 8 * fq);
      R.nq = *(const f32x2v*)(nqp + qrow * 8); }
}
DI void attn_phase(LAS unsigned char* lds, const PP& p, int gh_lo, int gh_hi, int mergepass) {
    const int tid = opaque_tid(), lane = tid & 63, wave = tid >> 6, fr = lane & 15, fq = lane >> 4;
    u16* qbuf = (u16*)(p.ws + WS_Q); const u16* kbuf = (const u16*)(p.ws + WS_K); const u16* vtb = (const u16*)((const unsigned char*)p.out() + OUT_VT);
    const float* nrm = (const float*)(p.ws + WS_NRM); float* lse = (float*)(p.ws + WS_LSE);
    const int G = gridDim.x;
    int su = gh_lo * 256 + blockIdx.x; const int su_end = gh_hi * 256;
    AttnRegs R;
    if (su < su_end) { const AttnGeo a0 = attn_geo(su); attn_issue<true, true>(a0, tid, wave, fr, fq, qbuf, kbuf, vtb, nrm, R); }
    while (su < su_end) {
        const AttnGeo a = attn_geo(su);
#pragma unroll
        for (int i = 0; i < 9; ++i) { const int pc = tid + 512 * i; if (pc < AK_ROWS * 16) *(LAS u32x4*)(lds + (pc >> 4) * AK_STRIDE + (pc & 15) * 16) = R.k[i]; }
#pragma unroll
        for (int i = 0; i < 9; ++i) { const int pc = tid + 512 * i; if (pc < AK_ROWS * 16) *(LAS u32x4*)(lds + AV_OFF + (pc >> 4) * AV_STRIDE + (pc & 15) * 16) = R.v[i]; }
        if (tid < AK_ROWS) *(LAS float*)(lds + ARK_OFF + tid * 4) = __builtin_amdgcn_rsqf((R.nk.x + R.nk.y) * (1.0f / 128.0f) + 1e-6f);
        bf16x8 Qf[4];
#pragma unroll
        for (int ks = 0; ks < 4; ++ks) Qf[ks] = R.q[ks];
        const float sq = __builtin_amdgcn_rsqf((R.nq.x + R.nq.y) * (1.0f / 128.0f) + 1e-6f) * 0.08838834764831845f;
        __syncthreads();
        const int nxt = su + G;
        int tidl = tid; asm volatile("" : "+v"(tidl));
        if (nxt < su_end) { const AttnGeo an = attn_geo(nxt); attn_issue<true, false>(an, tidl, tidl >> 6, tidl & 15, (tidl >> 4) & 3, qbuf, kbuf, vtb, nrm, R); }
        f32x4 Sc[9];
        const int jw = 16 * wave;
#pragma unroll
        for (int T = 0; T < 9; ++T) {
            f32x4 acc = {0.f, 0.f, 0.f, 0.f};
#pragma unroll
            for (int ks = 0; ks < 4; ++ks) { const bf16x8 kf = *(LAS const bf16x8*)(lds + (jw + 16 * T + fr) * AK_STRIDE + (32 * ks + 8 * fq) * 2);
                acc = __builtin_amdgcn_mfma_f32_16x16x32_bf16(kf, Qf[ks], acc, 0, 0, 0); }
            const f32x4 rk = *(LAS const f32x4*)(lds + ARK_OFF + (jw + 16 * T + 4 * fq) * 4);
#pragma unroll
            for (int r = 0; r < 4; ++r) {
                const int dd = 16 * T + 4 * fq + r - 64 - fr, kk = a.Q0 + jw + fr + dd;
                const bool ok = dd <= 64 && dd >= -64 && kk >= 0 && kk < a.L;
                Sc[T][r] = ok ? acc[r] * sq * rk[r] : -1e30f;
            }
        }
        float mx = -1e30f;
#pragma unroll
        for (int T = 0; T < 9; ++T)
#pragma unroll
            for (int r = 0; r < 4; ++r) mx = fmaxf(mx, Sc[T][r]);
        mx = fmaxf(mx, __shfl_xor(mx, 16)); mx = fmaxf(mx, __shfl_xor(mx, 32));
        float sum = 0.f;
#pragma unroll
        for (int T = 0; T < 9; ++T)
#pragma unroll
            for (int r = 0; r < 4; ++r) { const float ev = __expf(Sc[T][r] - mx); Sc[T][r] = ev; sum += ev; }
        sum += __shfl_xor(sum, 16); sum += __shfl_xor(sum, 32);
        const float linv = 1.0f / sum, lsev = mx + __logf(sum);
        if (nxt < su_end) { const AttnGeo an = attn_geo(nxt); attn_issue<false, true>(an, tidl, tidl >> 6, tidl & 15, (tidl >> 4) & 3, qbuf, kbuf, vtb, nrm, R); }
        f32x4 O[8];
#pragma unroll
        for (int dt = 0; dt < 8; ++dt) O[dt] = (f32x4){0.f, 0.f, 0.f, 0.f};
        {
            const unsigned vbase = (unsigned)(size_t)lds + AV_OFF + (jw + 4 * fq + (fr >> 2)) * AV_STRIDE + 8 * (fr & 3);
#define PFRAG(tp_, hi_) ({ u32x4 w_; w_[0] = pk2(Sc[2 * (tp_)][0], Sc[2 * (tp_)][1]); w_[1] = pk2(Sc[2 * (tp_)][2], Sc[2 * (tp_)][3]); \
            if (hi_) { w_[2] = pk2(Sc[(hi_) ? 2 * (tp_) + 1 : 0][0], Sc[(hi_) ? 2 * (tp_) + 1 : 0][1]); w_[3] = pk2(Sc[(hi_) ? 2 * (tp_) + 1 : 0][2], Sc[(hi_) ? 2 * (tp_) + 1 : 0][3]); } else { w_[2] = 0u; w_[3] = 0u; } \
            __builtin_bit_cast(bf16x8, w_); })
            pv_pair<0>(vbase, PFRAG(0, 1), O); pv_pair<1>(vbase, PFRAG(1, 1), O); pv_pair<2>(vbase, PFRAG(2, 1), O); pv_pair<3>(vbase, PFRAG(3, 1), O);
            pv_pair<4>(vbase, PFRAG(4, 0), O);
#undef PFRAG
        }
        {
            const size_t qrow = (size_t)(a.sbase + ((a.Q0 + jw + fr) << a.dsh) + a.rho);
            if (mergepass < 0) {
                u16* Q = qbuf + (size_t)a.gh * M * 128;
#pragma unroll
                for (int dt = 0; dt < 8; ++dt) { const f32x4 o = O[dt] * linv; u32x2 w; w.x = pk2(o[0], o[1]); w.y = pk2(o[2], o[3]); *(u32x2*)(Q + qrow * 128 + 16 * dt + 4 * fq) = w; }
                if (fq == 0) lse[(size_t)a.gh * M + qrow] = lsev;
            } else {
                const int hh = a.gh & 3;
                const u16* o0p = qbuf + ((size_t)(0 + hh) * M + qrow) * 128 + 4 * fq; const u16* o1p = qbuf + ((size_t)(4 + hh) * M + qrow) * 128 + 4 * fq;
                const float l0 = lse[(size_t)(0 + hh) * M + qrow], l1 = lse[(size_t)(4 + hh) * M + qrow];
                u32x2 a0[8], a1[8];
#pragma unroll
                for (int dt = 0; dt < 8; ++dt) { a0[dt] = *(const u32x2*)(o0p + 16 * dt); a1[dt] = *(const u32x2*)(o1p + 16 * dt); }
                const float mxl = fmaxf(l0, fmaxf(l1, lsev)); float w0 = __expf(l0 - mxl), w1 = __expf(l1 - mxl), w2 = __expf(lsev - mxl);
                const float inv = 1.0f / (w0 + w1 + w2); w0 *= inv; w1 *= inv; w2 *= inv * linv;
                u16* dst = (qrow < (size_t)S0 ? (u16*)(p.ws + WS_AO0) + qrow * D : (u16*)((unsigned char*)p.out() + OUT_AO1) + (qrow - S0) * D) + (4 * mergepass + hh) * 128 + 4 * fq;
#pragma unroll
                for (int dt = 0; dt < 8; ++dt) {
                    const f32x4 o = O[dt];
                    const float v0 = w0 * bf2f(a0[dt].x & 0xffffu) + w1 * bf2f(a1[dt].x & 0xffffu) + w2 * o[0], v1 = w0 * bf2f(a0[dt].x >> 16) + w1 * bf2f(a1[dt].x >> 16) + w2 * o[1];
                    const float v2 = w0 * bf2f(a0[dt].y & 0xffffu) + w1 * bf2f(a1[dt].y & 0xffffu) + w2 * o[2], v3 = w0 * bf2f(a0[dt].y >> 16) + w1 * bf2f(a1[dt].y >> 16) + w2 * o[3];
                    u32x2 w; w.x = pk2(v0, v1); w.y = pk2(v2, v3); *(u32x2*)(dst + 16 * dt) = w;
                }
            }
        }
        __syncthreads();
        su = nxt;
    }
}
DI void attn_merge(const PP& p, int pass) {
    const u16* qbuf = (const u16*)(p.ws + WS_Q); const float* lse = (const float*)(p.ws + WS_LSE);
    u16* ao0 = (u16*)(p.ws + WS_AO0); u16* ao1 = (u16*)((unsigned char*)p.out() + OUT_AO1);
    const int nth = gridDim.x * 512;
    for (int idx0 = blockIdx.x * 512 + opaque_tid(); idx0 < M * 64; idx0 += 2 * nth) {
        float l[2][3]; u32x4 a[2][3];
#pragma unroll
        for (int q = 0; q < 2; ++q) { int idx = idx0 + q * nth; if (idx >= M * 64) idx = idx0; const int c = idx & 15, hh = (idx >> 4) & 3, row = idx >> 6;
#pragma unroll
            for (int g = 0; g < 3; ++g) { l[q][g] = lse[(size_t)(4 * g + hh) * M + row]; a[q][g] = *(const u32x4*)(qbuf + ((size_t)(4 * g + hh) * M + row) * 128 + 8 * c); } }
#pragma unroll
        for (int q = 0; q < 2; ++q) { const int idx = idx0 + q * nth; if (idx >= M * 64) continue; const int c = idx & 15, hh = (idx >> 4) & 3, row = idx >> 6;
            const float mx = fmaxf(l[q][0], fmaxf(l[q][1], l[q][2])); float w0 = __expf(l[q][0] - mx), w1 = __expf(l[q][1] - mx), w2 = __expf(l[q][2] - mx);
            const float inv = 1.0f / (w0 + w1 + w2); w0 *= inv; w1 *= inv; w2 *= inv;
            u32x4 o;
#pragma unroll
            for (int e = 0; e < 4; ++e) {
                const float v0 = w0 * bf2f(a[q][0][e] & 0xffffu) + w1 * bf2f(a[q][1][e] & 0xffffu) + w2 * bf2f(a[q][2][e] & 0xffffu);
                const float v1 = w0 * bf2f(a[q][0][e] >> 16) + w1 * bf2f(a[q][1][e] >> 16) + w2 * bf2f(a[q][2][e] >> 16);
                o[e] = pk2(v0, v1);
            }
            u16* dst = row < S0 ? ao0 + (size_t)row * D : ao1 + (size_t)(row - S0) * D;
            *(u32x4*)(dst + (4 * pass + hh) * 128 + 8 * c) = o;
        }
    }
}

enum { K_PRO = 0, K_FFN1, K_RESID, K_LRUIN, K_L1, K_CARRY, K_L3, K_QKV, K_ATTN, K_MERGE };
__global__ void __launch_bounds__(512, 2) mega(Params p0) {
    extern __shared__ __attribute__((aligned(16))) unsigned char lds_raw[];
    LAS unsigned char* lds = (LAS unsigned char*)lds_raw;
    cg::grid_group grid = cg::this_grid();
    if (threadIdx.x < 19) { const float* const* src = (const float* const*)&p0; ((LAS unsigned long long*)(lds + PTR_OFF))[threadIdx.x] = (unsigned long long)src[threadIdx.x]; }
    unsigned char* ws0 = p0.ws;
    if (threadIdx.x < 4) ((LAS unsigned*)(lds + XBW_OFF))[threadIdx.x] = 0u;
    __syncthreads();
    XcdBarrier bar = xcd_barrier_post((unsigned*)(ws0 + WS_BAR), (volatile XLAS unsigned*)(lds + XBW_OFF));
#ifndef ONLY_KIND
    { PP p{lds + PTR_OFF, ws0}; prologue_x(p); rope_table(p, (int)blockIdx.x, (int)gridDim.x); }
#endif
#pragma unroll 1
    for (int ph = 0; ph < NPHASE; ++ph) {
        unsigned zoff = 0; asm volatile("" : "+s"(zoff)); unsigned char* ws = ws0 + zoff;
        const PP p{lds + PTR_OFF, ws};
        u16* xb = (u16*)(ws + WS_XB); float* ssq = (float*)(ws + WS_SSQ);
        int kind;
        if (ph == 0 || ph == 10) kind = K_PRO;
        else if (ph == 1 || ph == 8 || ph == 11 || ph == 20) kind = K_FFN1;
        else if (ph == 3) kind = K_LRUIN;
        else if (ph == 4) kind = K_L1;
        else if (ph == 5) kind = K_CARRY;
        else if (ph == 6) kind = K_L3;
        else if (ph >= 13 && ph <= 18) { const int s3 = (ph - 13) % 3; kind = s3 == 0 ? K_QKV : (s3 == 1 ? K_ATTN : K_MERGE); }
        else kind = K_RESID;
#define PH_A0 (kind == K_PRO ? (ph != 0 ? 1 : 0) : ((kind == K_QKV || kind == K_ATTN || kind == K_MERGE) ? (ph - 13) / 3 : (ph >= 11 ? 1 : 0)))
#define PH_A1 (kind == K_FFN1 ? ((ph == 8 || ph == 20) ? 1 : 0) : (ph == 7 ? 2 : (ph == 19 ? 3 : ((ph == 9 || ph == 21) ? 1 : 0))))

#ifdef ONLY_KIND
        if (kind != ONLY_KIND) continue;
#endif
#ifdef PROBE_DUP
        int nrep = (kind == PROBE_DUP) ? 2 : 1; asm volatile("" : "+v"(nrep)); nrep = __builtin_amdgcn_readfirstlane(nrep);
        for (int rep = 0; rep < nrep; ++rep) {
        int dry = (rep + 1 < nrep) ? 1 : 0; asm volatile("" : "+v"(dry)); dry = __builtin_amdgcn_readfirstlane(dry);
        if (rep) grid.sync();
#else
        const int dry = 0;
#endif
        switch (kind) {
        case K_PRO: { const int a0 = PH_A0;
            convert_weights((LAS float*)lds, p, a0);
        } break;
        case K_FFN1: { const int a1 = PH_A1;
            pg8::Gemm g{xb, (const u16*)(ws + (a1 == 0 ? W_FI0 : W_FI1)), M, 2 * FF, D, 0ll, 1 << 20}; pg8::StaticOrder S; S.init(M, 2 * FF, (int)gridDim.x, (int)blockIdx.x);
            EpiFFN1 E{(u16*)(ws + WS_HID), lds, 0}; fill_rstd(lds, ssq, S, opaque_tid());
#ifdef STAGGER_TICKS
            { const unsigned cls = (blockIdx.x >> 3) & 3u;
              if (cls) { const unsigned long long t0 = __builtin_amdgcn_s_memrealtime(); while (__builtin_amdgcn_s_memrealtime() - t0 < (unsigned long long)(cls * STAGGER_TICKS)) __builtin_amdgcn_s_sleep(8); } }
#endif
            pg8::gemm_phase<EpiFFN1, pg8::StaticOrder, false>(lds, g, S, E, nullptr);
        } break;
        case K_RESID: { const int a0 = PH_A0, a1 = PH_A1;
            pg8::Gemm g; EpiResid E; E.out = p.out(); E.xb = xb; E.ssq = ssq; E.base0 = p.in(0); E.base1 = p.in(1); E.bias = nullptr; E.scale = 1.0f; E.dry = dry; E.first = 0; E.last = (ph == NPHASE - 1);
            if (a1 < 2) { g = pg8::Gemm{(const u16*)(ws + WS_HID), (const u16*)(ws + (a1 == 0 ? W_FO0 : W_FO1)), M, D, FF, 0ll, 1 << 20}; E.scale = 0.5f;
                          if (a0 == 0 && a1 == 0) E.first = 1; }
            else if (a1 == 2) { g = pg8::Gemm{(const u16*)(ws + WS_YB), (const u16*)(ws + W_LRUOUT), M, D, D, 0ll, 1 << 20}; E.bias = p.in(13); }
            else { g = pg8::Gemm{(const u16*)(ws + WS_AO0), (const u16*)(ws + W_WO), M, D, D, (long long)((const unsigned char*)p.out() + OUT_AO1 - (ws + WS_AO0)) - (long long)S0 * D * 2, S0 / 256}; }
            pg8::StaticOrder S; S.init(M, D, (int)gridDim.x, (int)blockIdx.x); S.rev = a1 < 2 ? 1 : 0;
            pg8::gemm_phase<EpiResid, pg8::StaticOrder, false>(lds, g, S, E, nullptr);
        } break;
        case K_LRUIN: {
            pg8::Gemm g{xb, (const u16*)(ws + W_LRUIN), M, 2 * D, D, 0ll, 1 << 20}; pg8::StaticOrder S; S.init(M, 2 * D, (int)gridDim.x, (int)blockIdx.x);
            EpiLruIn E{(u16*)(ws + WS_YB), (u16*)(ws + WS_UB), lds, p.in(6), 0}; fill_rstd(lds, ssq, S, opaque_tid());
            pg8::gemm_phase<EpiLruIn, pg8::StaticOrder, false>(lds, g, S, E, nullptr);
        } break;
        case K_L1: lru_l1(lds, p, dry); break;
        case K_CARRY: {
            if ((int)gridDim.x > 2 * CARRY_WGS) {
                if ((int)blockIdx.x < CARRY_WGS) lru_carry(p);
                else { const int nb = (int)gridDim.x - CARRY_WGS, bb = (int)blockIdx.x - CARRY_WGS; convert_ffn10_early((LAS float*)lds, p, bb, nb); }
            } else lru_carry(p);
        } break;
        case K_L3: lru_l3(p); break;
        case K_QKV: { const int a0 = PH_A0;
            pg8::Gemm g{xb, (const u16*)(ws + W_QKV) + (size_t)a0 * 4608 * D, M, 4608, D, 0ll, 1 << 20}; pg8::StaticOrder S; S.init(M, 4608, (int)gridDim.x, (int)blockIdx.x);
            EpiQKV E{(u16*)(ws + WS_Q), (u16*)(ws + WS_K), (u16*)((unsigned char*)p.out() + OUT_VT), (float*)(ws + WS_NRM), lds, p.in(15), p.in(16), (const float*)(ws + WS_ROPE), 0}; fill_rstd(lds, ssq, S, opaque_tid());
            pg8::gemm_phase<EpiQKV, pg8::StaticOrder, false>(lds, g, S, E, nullptr);
        } break;
        case K_ATTN: case K_MERGE: { const int isb = kind == K_MERGE ? 1 : 0; attn_phase(lds, p, isb ? 8 : 0, isb ? 12 : 8, isb ? PH_A0 : -1); } break;
        }
#ifdef PROBE_DUP
        }
#endif
#ifdef PROBE_SYNC2
        grid.sync();
#endif
        if (zoff == 0x7fffffffu) grid.sync();
        if (ph != NPHASE - 1) xcd_barrier(bar);
    }
}

extern "C" void kernel_launch(void* const* d_in, const int* in_sizes, int n_in, void* d_out, int out_size, void* d_ws, size_t ws_size, hipStream_t stream) {
    static int grid_blocks = 0;
    if (grid_blocks == 0) {
        if (n_in != 18 || out_size != M * D || ws_size < WS_END) { fprintf(stderr, "kernel_launch: unexpected shapes (n_in %d out %d ws %zu need %zu)\n", n_in, out_size, ws_size, (size_t)WS_END); grid_blocks = -1; return; }
        int dev = 0, cus = 0, per_cu = 0;
        hipGetDevice(&dev); hipDeviceGetAttribute(&cus, hipDeviceAttributeMultiprocessorCount, dev);
        if (hipFuncSetAttribute((const void*)mega, hipFuncAttributeMaxDynamicSharedMemorySize, LDS_BYTES) != hipSuccess) { fprintf(stderr, "kernel_launch: hipFuncSetAttribute failed\n"); (void)hipGetLastError(); }
        if (hipOccupancyMaxActiveBlocksPerMultiprocessor(&per_cu, (const void*)mega, 512, LDS_BYTES) != hipSuccess || per_cu < 1) { fprintf(stderr, "kernel_launch: occupancy query says %d\n", per_cu); (void)hipGetLastError(); per_cu = 1; }
        grid_blocks = cus;
    }
    if (grid_blocks < 0) return;
    if (hipMemsetAsync((unsigned char*)d_ws + WS_BAR, 0, XCD_BAR_WORDS * 4, stream) != hipSuccess) { fprintf(stderr, "kernel_launch: memset failed\n"); return; }
    Params p{};
    for (int i = 0; i < 18; ++i) p.in[i] = (const float*)d_in[i];
    p.out = (float*)d_out; p.ws = (unsigned char*)d_ws;
    void* args[] = {&p};
    hipError_t e = hipLaunchCooperativeKernel((const void*)mega, dim3(grid_blocks), dim3(512), args, LDS_BYTES, stream);
    if (e != hipSuccess) fprintf(stderr, "cooperative launch failed: %s (grid %d)\n", hipGetErrorString(e), grid_blocks);
}
```
